# Optimizing an MI355X kernel written in HIP

```python
import jax, jax.numpy as jnp
from jax import lax
import numpy as np

D_MODEL = 1024
BATCH = 8
SEQ = 4096
DEPTH = 2

MEM_LEN = 256
HEAD_DIM = 64
D_CONV = 256
CONV_K = 3
N_SWA_HEADS = 8
N_SWA_KV = 2
WINDOW = 128
BLOCK = 128
N_MEM_HEADS = 4
D_SWA = N_SWA_HEADS * HEAD_DIM
D_KV = N_SWA_KV * HEAD_DIM
D_MEMQ = N_MEM_HEADS * HEAD_DIM
D_MIX = D_CONV + D_SWA + D_MEMQ
D_IN = 3 * D_CONV + D_SWA + 2 * D_KV + D_MEMQ
D_FF = 2816
EPS = 1e-6

kernel_name = "hymba_style_conv_swa_memory_macaron"


def _split_points():
    widths = [D_CONV, D_CONV, D_CONV, D_SWA, D_KV, D_KV]
    return [int(v) for v in np.cumsum(widths)]


def _rms(x):
    xf = x.astype(jnp.float32)
    return (xf * lax.rsqrt(jnp.mean(xf * xf, axis=-1, keepdims=True) + EPS)).astype(x.dtype)


def rmsnorm(x, g):
    xf = x.astype(jnp.float32)
    y = xf * lax.rsqrt(jnp.mean(xf * xf, axis=-1, keepdims=True) + EPS)
    return (y * g.astype(jnp.float32)).astype(x.dtype)


def swiglu(x, w_up, w_down):
    gate, up = jnp.split(x @ w_up, 2, axis=-1)
    return (jax.nn.silu(gate) * up) @ w_down


def alibi_slopes(n):
    return jnp.asarray([2.0 ** (-8.0 * (i + 1) / n) for i in range(n)], dtype=jnp.float32)


def short_conv_mixer(b_gate, c_gate, u, conv_w):
    seq = u.shape[1]
    v = c_gate * u
    vp = jnp.pad(v, ((0, 0), (CONV_K - 1, 0), (0, 0)))
    y = conv_w[0] * vp[:, 0:seq]
    for j in range(1, CONV_K):
        y = y + conv_w[j] * vp[:, j:j + seq]
    return b_gate * y


def sliding_window_attention(q, k, v, sinks, slopes):
    bsz, seq = q.shape[0], q.shape[1]
    nb = seq // BLOCK
    grp = N_SWA_HEADS // N_SWA_KV
    qb = q.reshape(bsz, nb, BLOCK, N_SWA_KV, grp, HEAD_DIM)

    def band(t):
        tb = t.reshape(bsz, nb, BLOCK, N_SWA_KV, HEAD_DIM)
        prev = jnp.pad(tb[:, :-1], ((0, 0), (1, 0), (0, 0), (0, 0), (0, 0)))
        return jnp.concatenate([prev, tb], axis=2)

    kb, vb = band(k), band(v)
    scores = jnp.einsum('bnqkgd,bnskd->bnkgqs', qb, kb).astype(jnp.float32) * (HEAD_DIM ** -0.5)
    qi = jnp.arange(BLOCK)[:, None]
    sj = jnp.arange(2 * BLOCK)[None, :]
    dist = qi + BLOCK - sj
    blk = jnp.arange(nb)[:, None, None]
    valid = ((dist >= 0) & (dist < WINDOW))[None] & ((blk > 0) | (sj[None] >= BLOCK))
    bias = -slopes.reshape(N_SWA_KV, grp)[:, :, None, None] * dist.astype(jnp.float32)
    scores = jnp.where(valid[None, :, None, None], scores + bias, -jnp.inf)
    sink = jnp.broadcast_to(sinks.astype(jnp.float32).reshape(N_SWA_KV, grp)[None, None, :, :, None, None],
                            scores.shape[:-1] + (1,))
    probs = jax.nn.softmax(jnp.concatenate([scores, sink], axis=-1), axis=-1)[..., :-1]
    out = jnp.einsum('bnkgqs,bnskd->bnqkgd', probs.astype(v.dtype), vb)
    return out.reshape(bsz, seq, D_SWA)


def memory_cross_attention(q, mk, mv):
    s = jnp.einsum('bqhd,bmhd->bhqm', q, mk).astype(jnp.float32) * (HEAD_DIM ** -0.5)
    p = jax.nn.softmax(s, axis=-1)
    out = jnp.einsum('bhqm,bmhd->bqhd', p.astype(mv.dtype), mv)
    return out.reshape(q.shape[0], q.shape[1], D_MEMQ)


def setup_inputs(seed: int = 0) -> dict:
    key = jax.random.key(seed)
    ks = jax.random.split(key, 20)
    f32 = jnp.float32

    def nrm(k, shape, scale):
        return jax.random.normal(k, shape, f32) * scale

    def gain(k, shape):
        return 1.0 + 0.02 * jax.random.normal(k, shape, f32)

    return {
        "x": jax.random.normal(ks[0], (BATCH, SEQ, D_MODEL), f32),
        "mem": jax.random.normal(ks[1], (BATCH, MEM_LEN, D_MODEL), f32),
        "g_ffn1": gain(ks[2], (DEPTH, D_MODEL)),
        "w_ffn1_up": nrm(ks[3], (DEPTH, D_MODEL, 2 * D_FF), D_MODEL ** -0.5),
        "w_ffn1_down": nrm(ks[4], (DEPTH, D_FF, D_MODEL), D_FF ** -0.5),
        "g_mix": gain(ks[5], (DEPTH, D_MODEL)),
        "w_in": nrm(ks[6], (DEPTH, D_MODEL, D_IN), D_MODEL ** -0.5),
        "conv_w": nrm(ks[7], (DEPTH, CONV_K, D_CONV), CONV_K ** -0.5),
        "sinks": nrm(ks[8], (DEPTH, N_SWA_HEADS), 1.0),
        "g_mem": gain(ks[9], (DEPTH, D_MODEL)),
        "w_mem_kv": nrm(ks[10], (DEPTH, D_MODEL, 2 * D_MEMQ), D_MODEL ** -0.5),
        "g_grp": gain(ks[11], (DEPTH, D_MIX)),
        "w_out": nrm(ks[12], (DEPTH, D_MIX, D_MODEL), D_MIX ** -0.5),
        "g_ffn2": gain(ks[13], (DEPTH, D_MODEL)),
        "w_ffn2_up": nrm(ks[14], (DEPTH, D_MODEL, 2 * D_FF), D_MODEL ** -0.5),
        "w_ffn2_down": nrm(ks[15], (DEPTH, D_FF, D_MODEL), D_FF ** -0.5),
        "g_final": gain(ks[16], (D_MODEL,)),
    }


def reference(x, mem, g_ffn1, w_ffn1_up, w_ffn1_down, g_mix, w_in, conv_w, sinks, g_mem,
              w_mem_kv, g_grp, w_out, g_ffn2, w_ffn2_up, w_ffn2_down, g_final):
    bsz, seq = x.shape[0], x.shape[1]
    mem_len = mem.shape[1]
    slopes = alibi_slopes(N_SWA_HEADS)
    cuts = _split_points()
    h = x
    for l in range(DEPTH):
        h = h + 0.5 * swiglu(rmsnorm(h, g_ffn1[l]), w_ffn1_up[l], w_ffn1_down[l])

        n = rmsnorm(h, g_mix[l])
        proj = n @ w_in[l]
        b_g, c_g, u, q, k, v, qm = jnp.split(proj, cuts, axis=-1)

        y_conv = short_conv_mixer(b_g, c_g, u, conv_w[l])

        y_swa = sliding_window_attention(
            q.reshape(bsz, seq, N_SWA_HEADS, HEAD_DIM),
            k.reshape(bsz, seq, N_SWA_KV, HEAD_DIM),
            v.reshape(bsz, seq, N_SWA_KV, HEAD_DIM),
            sinks[l], slopes)

        mkv = rmsnorm(mem, g_mem[l]) @ w_mem_kv[l]
        mk, mv = jnp.split(mkv, 2, axis=-1)
        y_mem = memory_cross_attention(
            qm.reshape(bsz, seq, N_MEM_HEADS, HEAD_DIM),
            mk.reshape(bsz, mem_len, N_MEM_HEADS, HEAD_DIM),
            mv.reshape(bsz, mem_len, N_MEM_HEADS, HEAD_DIM))

        mixed = jnp.concatenate([_rms(y_conv), _rms(y_swa), _rms(y_mem)], axis=-1) * g_grp[l]
        h = h + mixed @ w_out[l]

        h = h + 0.5 * swiglu(rmsnorm(h, g_ffn2[l]), w_ffn2_up[l], w_ffn2_down[l])
    return rmsnorm(h, g_final)
```

```cpp
#include <hip/hip_runtime.h>
#include <hip/hip_cooperative_groups.h>
#include <cstdio>
#include <cstdint>
namespace cg = cooperative_groups;
#ifndef MK_ONE_LAUNCH
#define MK_ONE_LAUNCH 1
#endif
#ifndef MK_DUP
#define MK_DUP 0
#endif
#ifndef MK_SKIPEPI
#define MK_SKIPEPI 0
#endif
#ifndef MK_MIXVAR
#define MK_MIXVAR 0
#endif
#ifndef MK_DUPN
#define MK_DUPN 1
#endif
#ifndef MK_NST_UP
#define MK_NST_UP 8
#endif
#ifndef MK_NST_RES
#define MK_NST_RES 0
#endif
#ifndef MK_NST_SC
#define MK_NST_SC 0
#endif
#ifndef MK_REV
#define MK_REV 1
#endif

#ifndef MK_FUSE_FINAL
#define MK_FUSE_FINAL 0
#endif

#ifndef MK_DEFER
#define MK_DEFER 0
#endif

#ifndef MK_STAG
#define MK_STAG 3
#endif

#ifndef MK_WSTAG
#define MK_WSTAG 4
#endif

#ifndef MK_STAG4
#define MK_STAG4 1
#endif

#ifndef MK_STAGR
#define MK_STAGR 1
#endif
namespace pg8 {
#define PG8_LAS __attribute__((address_space(3)))
typedef unsigned short bf16_t;
typedef short bf16x8 __attribute__((ext_vector_type(8)));
typedef float f32x4 __attribute__((ext_vector_type(4)));
typedef unsigned u32x4 __attribute__((ext_vector_type(4)));
constexpr int BM = 256, BK = 64, HALF = 128, HTB = HALF * BK * 2  , STAGE_BYTES = 8 * HTB, NXCD = 8, WGM = 8;

__host__ __device__ __forceinline__ int lds_byte(int r, int c) { const int st = (r >> 4) * 2 + (c >> 5), rr = r & 15, cc = c & 31, ob = rr * 64 + cc * 2; return st * 1024 + (ob ^ (((ob >> 9) & 1) << 5)); }
__host__ __device__ __forceinline__ void stage_rc(int b, int& R, int& C) { const int st = b / 1024, sb = b % 1024, swz = sb ^ (((sb >> 9) & 1) << 5); R = (st >> 1) * 16 + swz / 64; C = (st & 1) * 32 + (swz % 64) / 2; }
__host__ __device__ __forceinline__ int perm32(int rho) { const int n = rho >> 4, i = rho & 15; return 8 * (i >> 2) + 4 * n + (i & 3); }

struct Unit { int pm, pn; };
struct Gemm { const bf16_t* A; const bf16_t* Bt; int M, N, K; };

struct StaticOrder {
    int nM, nN, nwg, G, c; int rev = 0;
    __host__ __device__ void init(int M, int N, int G_, int c_) { nM = M / BM; nN = N / BM; nwg = nM * nN; G = G_; c = c_; }
    __host__ __device__ bool next(int i, Unit& u) const {
        const long L = (long)i * G + c; if (L >= nwg) return false;
        int wgid = rev ? (nwg - 1 - (int)L) : (int)L; { const int q = nwg / NXCD, r = nwg % NXCD, xcd = wgid % NXCD, off = wgid / NXCD; wgid = (xcd < r ? xcd * (q + 1) : r * (q + 1) + (xcd - r) * q) + off; }
        const int nig = WGM * nN, gid = wgid / nig, fm = gid * WGM, gsz = (nM - fm) < WGM ? (nM - fm) : WGM;
        u.pm = fm + ((wgid % nig) % gsz); u.pn = (wgid % nig) / gsz; return true;
    }
    __device__ __forceinline__ void a_ready(const Unit&) const {}
    __device__ __forceinline__ void done(const Unit&) const {}
};

__device__ __forceinline__ unsigned cvt_pk_bf16(float lo, float hi) { unsigned r; asm volatile("v_cvt_pk_bf16_f32 %0, %1, %2" : "=v"(r) : "v"(lo), "v"(hi)); return r; }
typedef float f32x2 __attribute__((ext_vector_type(2)));

template <class Epi, class Sched, bool ALIGN_EPI = false, bool SP2 = false>
__device__ __forceinline__ void gemm_phase(PG8_LAS unsigned char* lds, const Gemm g, const Sched& S, const Epi& E, const int tid) {
    const int wid = __builtin_amdgcn_readfirstlane(tid >> 6), lane = tid & 63, wr = wid >> 2, wc = wid & 3, fr = lane & 15, fq = lane >> 4;
    const int K = g.K, nt = K / BK;
    unsigned voffA[2], voffB[2];
#pragma unroll
    for (int i = 0; i < 2; ++i) { int R, C; stage_rc(tid * 16 + i * 8192, R, C); const int Rb = Epi::PERM ? ((R & ~31) + perm32(R & 31)) : R;
        voffA[i] = (unsigned)(R * K + C) * 2u; voffB[i] = (unsigned)(Rb * K + C) * 2u; }
    const size_t kstep = (size_t)(BK * 2);
    const size_t hstep = (size_t)HALF * K * 2;
    const size_t tstep = 2 * hstep;
    const unsigned ldsw = (unsigned)wid * 1024u;
    const int aoff = lds_byte(wr * 64 + fr, fq * 8), boff = lds_byte(wc * 32 + fr, fq * 8);
#define PG8_SA(b, h) (((b) * 2 + (h)) * HTB)
#define PG8_SB(b, h) ((4 + (b) * 2 + (h)) * HTB)
#define PG8_STAGE(bufoff, gbase, voff) do { _Pragma("unroll") for (int _i = 0; _i < 2; ++_i) \
        __builtin_amdgcn_global_load_lds((const unsigned*)((const char*)(gbase) + (voff)[_i]), (PG8_LAS unsigned*)(lds + (bufoff) + ldsw + _i * 8192), 16, 0, 0); } while (0)
#define PG8_LDA(dst, b, h) do { _Pragma("unroll") for (int m = 0; m < 4; ++m) _Pragma("unroll") for (int k = 0; k < 2; ++k) dst[m][k] = *(const PG8_LAS bf16x8*)(lds + PG8_SA(b, h) + aoff + m * 2048 + k * 1024); } while (0)
#define PG8_LDB(dst, b, h) do { _Pragma("unroll") for (int n = 0; n < 2; ++n) _Pragma("unroll") for (int k = 0; k < 2; ++k) dst[n][k] = *(const PG8_LAS bf16x8*)(lds + PG8_SB(b, h) + boff + n * 2048 + k * 1024); } while (0)
#define PG8_MMA(ai, bj, At, Bt) do { __builtin_amdgcn_s_setprio(1); _Pragma("unroll") for (int m = 0; m < 4; ++m) _Pragma("unroll") for (int n = 0; n < 2; ++n) _Pragma("unroll") for (int k = 0; k < 2; ++k) \
        acc[ai][bj][m][n] = __builtin_amdgcn_mfma_f32_16x16x32_bf16(Bt[n][k], At[m][k], acc[ai][bj][m][n], 0, 0, 0); __builtin_amdgcn_s_setprio(0); } while (0)
#define PG8_WAIT_V(n) asm volatile("s_waitcnt vmcnt(" #n ")" ::: "memory")
#define PG8_WAIT_VR(rx) asm volatile("s_cmp_eq_u32 %0, 0\n\ts_cbranch_scc1 2\n\ts_waitcnt vmcnt(%1)\n\ts_branch 1\n\ts_waitcnt vmcnt(8)" :: "s"(rx), "n"(8 + Epi::NST) : "memory", "scc")
#define PG8_WAIT_L(n) asm volatile("s_waitcnt lgkmcnt(" #n ")" ::: "memory")
#define PG8_BAR __builtin_amdgcn_s_barrier()
#define PG8_SCHED __builtin_amdgcn_sched_barrier(0)
    Unit cur, nxt; int ui = 0;
    if (!S.next(0, cur)) return;
    f32x4 acc[2][2][4][2];
#pragma unroll
    for (int a = 0; a < 2; ++a)
#pragma unroll
        for (int b = 0; b < 2; ++b)
#pragma unroll
            for (int m = 0; m < 4; ++m)
#pragma unroll
                for (int n = 0; n < 2; ++n) acc[a][b][m][n] = (f32x4){0.f, 0.f, 0.f, 0.f};
    bf16x8 At[4][2], B0[2][2], B1[2][2];
    const char* cA = (const char*)g.A + (size_t)cur.pm * tstep; const char* cB = (const char*)g.Bt + (size_t)cur.pn * tstep;
    S.a_ready(cur);
    if constexpr (SP2) {
        PG8_STAGE(PG8_SB(0, 0), cB, voffB); PG8_STAGE(PG8_SB(0, 1), cB + hstep, voffB); PG8_STAGE(PG8_SA(0, 0), cA, voffA); PG8_STAGE(PG8_SA(0, 1), cA + hstep, voffA);
        if (wr == 1) PG8_BAR;
        PG8_WAIT_V(2); PG8_BAR;
        PG8_STAGE(PG8_SB(1, 0), cB + kstep, voffB); PG8_STAGE(PG8_SA(1, 0), cA + kstep, voffA); PG8_STAGE(PG8_SB(1, 1), cB + hstep + kstep, voffB);
        PG8_WAIT_V(6); PG8_BAR;
    } else {
        PG8_STAGE(PG8_SB(0, 0), cB, voffB); PG8_STAGE(PG8_SA(0, 0), cA, voffA); PG8_STAGE(PG8_SB(0, 1), cB + hstep, voffB); PG8_STAGE(PG8_SA(0, 1), cA + hstep, voffA);
        if (wr == 1) PG8_BAR;
        PG8_WAIT_V(4); PG8_BAR;
        PG8_STAGE(PG8_SB(1, 0), cB + kstep, voffB); PG8_STAGE(PG8_SA(1, 0), cA + kstep, voffA); PG8_STAGE(PG8_SB(1, 1), cB + hstep + kstep, voffB);
        PG8_WAIT_V(6); PG8_BAR;
    }
    for (;;) {
        const bool has_next = S.next(ui + 1, nxt);
        const char* nA = has_next ? (const char*)g.A + (size_t)nxt.pm * tstep : cA; const char* nB = has_next ? (const char*)g.Bt + (size_t)nxt.pn * tstep : cB;
        for (int t = 0; t < nt; t += 2) {
            const bool last = (t == nt - 2);
            const char* a1 = cA + (size_t)(t + 1) * kstep;
            const char* a2 = last ? nA : cA + (size_t)(t + 2) * kstep; const char* b2 = last ? nB : cB + (size_t)(t + 2) * kstep;
            const char* a3 = a2 + kstep; const char* b3 = b2 + kstep;
            if (last && has_next) S.a_ready(nxt);
            if constexpr (SP2) {
            PG8_LDB(B0, 0, 0); PG8_LDB(B1, 0, 1); PG8_SCHED; PG8_LDA(At, 0, 0); PG8_STAGE(PG8_SA(1, 1), a1 + hstep, voffA);
            PG8_WAIT_V(8); PG8_WAIT_L(0); PG8_BAR; PG8_MMA(0, 0, At, B0); PG8_MMA(0, 1, At, B1); PG8_BAR; PG8_SCHED;
            PG8_LDA(At, 0, 1); PG8_STAGE(PG8_SB(0, 0), b2, voffB); PG8_STAGE(PG8_SB(0, 1), b2 + hstep, voffB); PG8_STAGE(PG8_SA(0, 0), a2, voffA);
            PG8_WAIT_V(8); PG8_WAIT_L(0); PG8_BAR; PG8_MMA(1, 0, At, B0); PG8_MMA(1, 1, At, B1); PG8_BAR; PG8_SCHED;
            PG8_LDB(B0, 1, 0); PG8_LDB(B1, 1, 1); PG8_SCHED; PG8_LDA(At, 1, 0); PG8_STAGE(PG8_SA(0, 1), a2 + hstep, voffA);
            PG8_WAIT_V(8); PG8_WAIT_L(0); PG8_BAR; PG8_MMA(0, 0, At, B0); PG8_MMA(0, 1, At, B1); PG8_BAR; PG8_SCHED;
            PG8_LDA(At, 1, 1); PG8_STAGE(PG8_SB(1, 0), b3, voffB); PG8_STAGE(PG8_SB(1, 1), b3 + hstep, voffB); PG8_STAGE(PG8_SA(1, 0), a3, voffA);
            PG8_WAIT_V(8); PG8_WAIT_L(0); PG8_BAR; PG8_MMA(1, 0, At, B0); PG8_MMA(1, 1, At, B1); PG8_BAR; PG8_SCHED;
            } else {
            PG8_LDB(B0, 0, 0); PG8_SCHED; PG8_LDA(At, 0, 0); PG8_STAGE(PG8_SA(1, 1), a1 + hstep, voffA);
            PG8_WAIT_L(8); PG8_BAR; PG8_WAIT_L(0); PG8_MMA(0, 0, At, B0); PG8_BAR; PG8_SCHED;
            PG8_LDB(B1, 0, 1); PG8_STAGE(PG8_SB(0, 0), b2, voffB);
            PG8_BAR; PG8_WAIT_L(0); PG8_MMA(0, 1, At, B1); PG8_BAR;
            PG8_LDA(At, 0, 1); PG8_STAGE(PG8_SA(0, 0), a2, voffA);
            PG8_BAR; PG8_WAIT_L(0); PG8_MMA(1, 0, At, B0); PG8_BAR; PG8_SCHED;
            PG8_STAGE(PG8_SB(0, 1), b2 + hstep, voffB);
            PG8_WAIT_V(6); PG8_BAR; PG8_MMA(1, 1, At, B1); PG8_BAR;
            PG8_LDB(B0, 1, 0); PG8_SCHED; PG8_LDA(At, 1, 0); PG8_STAGE(PG8_SA(0, 1), a2 + hstep, voffA);
            PG8_WAIT_L(8); PG8_BAR; PG8_WAIT_L(0); PG8_MMA(0, 0, At, B0); PG8_BAR; PG8_SCHED;
            PG8_LDB(B1, 1, 1); PG8_STAGE(PG8_SB(1, 0), b3, voffB);
            PG8_BAR; PG8_WAIT_L(0); PG8_MMA(0, 1, At, B1); PG8_BAR;
            PG8_LDA(At, 1, 1); PG8_STAGE(PG8_SA(1, 0), a3, voffA);
            PG8_BAR; PG8_WAIT_L(0); PG8_MMA(1, 0, At, B0); PG8_BAR; PG8_SCHED;
            PG8_STAGE(PG8_SB(1, 1), b3 + hstep, voffB);
            PG8_WAIT_V(6); PG8_BAR; PG8_MMA(1, 1, At, B1); PG8_BAR;
            }
        }
        if constexpr (ALIGN_EPI) { if (wr == 0) PG8_BAR; }
        if constexpr (!Epi::AFTER_DRAIN) { E(acc, cur, wr, wc, fr, fq); S.done(cur); }
        if (!has_next) break;
#pragma unroll
        for (int a = 0; a < 2; ++a)
#pragma unroll
            for (int b = 0; b < 2; ++b)
#pragma unroll
                for (int m = 0; m < 4; ++m)
#pragma unroll
                    for (int n = 0; n < 2; ++n) acc[a][b][m][n] = (f32x4){0.f, 0.f, 0.f, 0.f};
        cur = nxt; cA = nA; cB = nB; ++ui;
        if constexpr (ALIGN_EPI) { if (wr == 1) PG8_BAR; }
    }
    PG8_WAIT_V(0);
    if constexpr (!ALIGN_EPI) { if (wr == 0) PG8_BAR; }
    PG8_BAR;
    if constexpr (Epi::AFTER_DRAIN) { E.fused(acc, cur, wr, wc, fr, fq, lds, wid, lane); S.done(cur); }
#undef PG8_SA
#undef PG8_SB
#undef PG8_STAGE
#undef PG8_LDA
#undef PG8_LDB
#undef PG8_MMA
#undef PG8_WAIT_V
#undef PG8_WAIT_VR
#undef PG8_WAIT_L
#undef PG8_BAR
#undef PG8_SCHED
}
}

#define LAS __attribute__((address_space(3)))
typedef unsigned short bf16;
typedef short bf16x8 __attribute__((ext_vector_type(8)));
typedef short s16x4 __attribute__((ext_vector_type(4)));
typedef float f32x4 __attribute__((ext_vector_type(4)));
typedef float f32x2 __attribute__((ext_vector_type(2)));
typedef float f32x16 __attribute__((ext_vector_type(16)));
typedef unsigned u32x4 __attribute__((ext_vector_type(4)));
typedef unsigned u32x2 __attribute__((ext_vector_type(2)));
typedef __bf16 bf16x2_t __attribute__((ext_vector_type(2)));

constexpr int NTOK = 32768, DM = 1024, DFF = 2816, DIN = 1792, SEQ = 4096, NBATCH = 8, MEML = 256, NMEM = NBATCH * MEML;
constexpr float EPS = 1e-6f;
constexpr float LOG2E = 1.4426950408889634f;
constexpr size_t MiB = (size_t)1 << 20;
constexpr size_t WS_SS = 0, WS_MK = 2 * MiB, WS_VT = 4 * MiB, WS_WMK = 6 * MiB, WS_WMV = 7 * MiB, WS_MEMN = 8 * MiB, WS_MEMNP = 12 * MiB;
constexpr size_t WS_W0 = 16 * MiB, WS_WL = 40 * MiB;
constexpr size_t OFF_WUP1 = 0, OFF_WDN1 = OFF_WUP1 + (size_t)5632 * 1024 * 2, OFF_WIN = OFF_WDN1 + (size_t)1024 * 2816 * 2, OFF_WOUT = OFF_WIN + (size_t)1792 * 1024 * 2,
                 OFF_WUP2 = OFF_WOUT + (size_t)1024 * 1024 * 2, OFF_WDN2 = OFF_WUP2 + (size_t)5632 * 1024 * 2, OFF_WEND = OFF_WDN2 + (size_t)1024 * 2816 * 2;
static_assert(OFF_WEND <= WS_WL, "weight block");
constexpr size_t WS_HB = 96 * MiB, WS_ACT = 160 * MiB, WS_P = WS_ACT, WS_MIXED = WS_ACT + 112 * MiB, WS_END = WS_ACT + 176 * MiB;
constexpr size_t WS_CTL = WS_END, CTL_BYTES = 16384, WS_TOTAL = WS_END + CTL_BYTES;
constexpr int LDS_BYTES = 147456, LDS_BARW = LDS_BYTES - 64;
constexpr int NPHASE = 16;

__device__ __forceinline__ unsigned cvtpk(float lo, float hi) { f32x2 v = {lo, hi}; bf16x2_t b = __builtin_convertvector(v, bf16x2_t); return __builtin_bit_cast(unsigned, b); }
__device__ __forceinline__ void unpack8(const u32x4 w, float (&f)[8]) {
    f[0] = __uint_as_float(w.x << 16); f[1] = __uint_as_float(w.x & 0xffff0000u); f[2] = __uint_as_float(w.y << 16); f[3] = __uint_as_float(w.y & 0xffff0000u);
    f[4] = __uint_as_float(w.z << 16); f[5] = __uint_as_float(w.z & 0xffff0000u); f[6] = __uint_as_float(w.w << 16); f[7] = __uint_as_float(w.w & 0xffff0000u);
}
__device__ __forceinline__ float xsum32(float v) { const auto rr = __builtin_amdgcn_permlane32_swap(__float_as_uint(v), __float_as_uint(v), false, false); return __uint_as_float(rr[0]) + __uint_as_float(rr[1]); }
__device__ __forceinline__ float xmax32(float v) { const auto rr = __builtin_amdgcn_permlane32_swap(__float_as_uint(v), __float_as_uint(v), false, false); return fmaxf(__uint_as_float(rr[0]), __uint_as_float(rr[1])); }
__device__ __forceinline__ float xsum16(float v) { const auto rr = __builtin_amdgcn_permlane16_swap(__float_as_uint(v), __float_as_uint(v), false, false); return __uint_as_float(rr[0]) + __uint_as_float(rr[1]); }
__device__ __forceinline__ float wave_sum(float v) {
#pragma unroll
    for (int o = 1; o < 64; o <<= 1) v += __shfl_xor(v, o);
    return v;
}
__device__ __forceinline__ float row_rstd(const float* ss, int row) {
    const f32x4* p = (const f32x4*)(ss + (size_t)row * 16);
    const f32x4 a = p[0], b = p[1], c = p[2], d = p[3];
    const float s = (((a.x + a.y) + (a.z + a.w)) + ((b.x + b.y) + (b.z + b.w))) + (((c.x + c.y) + (c.z + c.w)) + ((d.x + d.y) + (d.z + d.w)));
    return __builtin_amdgcn_rsqf(s * (1.0f / 1024.0f) + EPS);
}
__device__ __forceinline__ void rows_rstd(const float* ss, int row0, int fq, float (&r)[8]) {
    f32x4 p[8];
#pragma unroll
    for (int i = 0; i < 8; ++i) p[i] = *(const f32x4*)(ss + (size_t)(row0 + (i >> 2) * 128 + (i & 3) * 16) * 16 + 4 * fq);
#pragma unroll
    for (int i = 0; i < 8; ++i) { float t = (p[i].x + p[i].y) + (p[i].z + p[i].w); t = xsum16(t); t = xsum32(t); r[i] = __builtin_amdgcn_rsqf(t * (1.0f / 1024.0f) + EPS); }
}
__device__ __forceinline__ float silu_f(float x) { return x * __builtin_amdgcn_rcpf(1.0f + __builtin_amdgcn_exp2f(-x * LOG2E)); }

struct EpiSwiglu {
    static constexpr bool PERM = true, AFTER_DRAIN = false;
    bf16* O; const float* ss; int skip;
    __device__ __forceinline__ void operator()(const pg8::f32x4 (&acc)[2][2][4][2], const pg8::Unit& u, int wr, int wc, int fr, int fq) const {
        if (skip == 1) return;
        const int row0 = u.pm * 256 + wr * 64 + fr, col0 = u.pn * 128 + wc * 32 + 8 * fq;
        float rr[8];
        if (skip == 2) {
#pragma unroll
            for (int i = 0; i < 8; ++i) rr[i] = 1.0f; } else rows_rstd(ss, row0, fq, rr);
#pragma unroll
        for (int ai = 0; ai < 2; ++ai)
#pragma unroll
            for (int m = 0; m < 4; ++m) {
                const int row = row0 + ai * 128 + m * 16; const float r = rr[ai * 4 + m];
                const f32x4 g0 = acc[ai][0][m][0] * r, g1 = acc[ai][0][m][1] * r, u0 = acc[ai][1][m][0] * r, u1 = acc[ai][1][m][1] * r;
                u32x4 w;
                if (skip == 2) { w.x = cvtpk(g0[0] * u0[0], g0[1] * u0[1]); w.y = cvtpk(g0[2] * u0[2], g0[3] * u0[3]); w.z = cvtpk(g1[0] * u1[0], g1[1] * u1[1]); w.w = cvtpk(g1[2] * u1[2], g1[3] * u1[3]); }
                else {
                w.x = cvtpk(silu_f(g0[0]) * u0[0], silu_f(g0[1]) * u0[1]); w.y = cvtpk(silu_f(g0[2]) * u0[2], silu_f(g0[3]) * u0[3]);
                w.z = cvtpk(silu_f(g1[0]) * u1[0], silu_f(g1[1]) * u1[1]); w.w = cvtpk(silu_f(g1[2]) * u1[2], silu_f(g1[3]) * u1[3]); }
                if (skip != 3 || (w.x == 0x7fc1a5a5u && w.y == 0x12345678u)) *(u32x4*)(O + (size_t)row * DFF + col0) = w;
            }
    }
};
struct EpiResid {
    static constexpr bool PERM = true, AFTER_DRAIN = false;
    bf16* hb; float* ss; float scale;
    __device__ __forceinline__ void operator()(const pg8::f32x4 (&acc)[2][2][4][2], const pg8::Unit& u, int wr, int wc, int fr, int fq) const {
        const int row0 = u.pm * 256 + wr * 64 + fr, col0 = u.pn * 256 + wc * 32 + 8 * fq;
        u32x4 bv[4][2];
#pragma unroll
        for (int m = 0; m < 4; ++m)
#pragma unroll
            for (int bj = 0; bj < 2; ++bj) bv[m][bj] = *(const u32x4*)(hb + (size_t)(row0 + m * 16) * DM + col0 + bj * 128);
        asm volatile("" ::: "memory");
#pragma unroll
        for (int ai = 0; ai < 2; ++ai)
#pragma unroll
            for (int m = 0; m < 4; ++m) {
                const int row = row0 + ai * 128 + m * 16; float sq = 0.f;
#pragma unroll
                for (int bj = 0; bj < 2; ++bj) {
                    const size_t off = (size_t)row * DM + col0 + bj * 128;
                    float b[8]; unpack8(bv[m][bj], b);
                    if (ai == 0) bv[m][bj] = *(const u32x4*)(hb + off + (size_t)128 * DM);
                    const f32x4 a0 = acc[ai][bj][m][0] * scale, a1 = acc[ai][bj][m][1] * scale;
                    const float v0 = b[0] + a0[0], v1 = b[1] + a0[1], v2 = b[2] + a0[2], v3 = b[3] + a0[3], v4 = b[4] + a1[0], v5 = b[5] + a1[1], v6 = b[6] + a1[2], v7 = b[7] + a1[3];
                    u32x4 w; w.x = cvtpk(v0, v1); w.y = cvtpk(v2, v3); w.z = cvtpk(v4, v5); w.w = cvtpk(v6, v7);
                    *(u32x4*)(hb + off) = w;
                    sq += ((v0 * v0 + v1 * v1) + (v2 * v2 + v3 * v3)) + ((v4 * v4 + v5 * v5) + (v6 * v6 + v7 * v7));
                }
                sq = xsum16(sq); sq = xsum32(sq);
                if (fq == 0) ss[(size_t)row * 16 + u.pn * 4 + wc] = sq;
            }
    }
};
struct EpiScaleBf16 {
    static constexpr bool PERM = true, AFTER_DRAIN = false;
    bf16* O; int ldc; const float* ss;
    __device__ __forceinline__ void operator()(const pg8::f32x4 (&acc)[2][2][4][2], const pg8::Unit& u, int wr, int wc, int fr, int fq) const {
        const int row0 = u.pm * 256 + wr * 64 + fr, col0 = u.pn * 256 + wc * 32 + 8 * fq;
        float rr[8];
        if (ss) rows_rstd(ss, row0, fq, rr); else {
#pragma unroll
            for (int i = 0; i < 8; ++i) rr[i] = 1.0f; }
#pragma unroll
        for (int ai = 0; ai < 2; ++ai)
#pragma unroll
            for (int m = 0; m < 4; ++m) {
                const int row = row0 + ai * 128 + m * 16; const float r = rr[ai * 4 + m];
#pragma unroll
                for (int bj = 0; bj < 2; ++bj) {
                    const f32x4 v0 = acc[ai][bj][m][0] * r, v1 = acc[ai][bj][m][1] * r;
                    u32x4 w; w.x = cvtpk(v0[0], v0[1]); w.y = cvtpk(v0[2], v0[3]); w.z = cvtpk(v1[0], v1[1]); w.w = cvtpk(v1[2], v1[3]);
                    *(u32x4*)(O + (size_t)row * ldc + col0 + bj * 128) = w;
                }
            }
    }
};

__device__ __forceinline__ void tr_item(const float* __restrict__ W, int ldw, int K, const float* __restrict__ g, bf16* __restrict__ WT, int item, int nblk, int mode, int row_off, LAS float* scr, int lane) {
    const int kb = item / nblk, nb = item - kb * nblk, k0 = 64 * kb, n0 = 32 * nb;
    int drow;
    if (mode) { const int bj = n0 / DFF, rem = n0 - bj * DFF; drow = 256 * (rem >> 7) + 128 * bj + (rem & 127); } else drow = row_off + n0;
    {
        const int kq = lane >> 3, n4 = (lane & 7) * 4; f32x4 v[8]; float gv[8];
#pragma unroll
        for (int i = 0; i < 8; ++i) { v[i] = *(const f32x4*)(W + (size_t)(k0 + kq + 8 * i) * ldw + n0 + n4); gv[i] = g ? g[k0 + kq + 8 * i] : 1.0f; }
#pragma unroll
        for (int i = 0; i < 8; ++i) { LAS float* d = scr + (kq + 8 * i) * 33 + n4; d[0] = v[i].x * gv[i]; d[1] = v[i].y * gv[i]; d[2] = v[i].z * gv[i]; d[3] = v[i].w * gv[i]; }
    }
    asm volatile("s_waitcnt lgkmcnt(0)" ::: "memory");
    const int c = lane & 7;
#pragma unroll
    for (int j = 0; j < 4; ++j) { const int n = (lane >> 3) + 8 * j; const LAS float* s = scr + (8 * c) * 33 + n;
        u32x4 o; o.x = cvtpk(s[0 * 33], s[1 * 33]); o.y = cvtpk(s[2 * 33], s[3 * 33]); o.z = cvtpk(s[4 * 33], s[5 * 33]); o.w = cvtpk(s[6 * 33], s[7 * 33]);
        *(u32x4*)(WT + (size_t)(drow + n) * K + k0 + 8 * c) = o; }
    asm volatile("s_waitcnt lgkmcnt(0)" ::: "memory");
}

struct Args { const float *x, *mem, *g_ffn1, *w_ffn1_up, *w_ffn1_down, *g_mix, *w_in, *conv_w, *sinks, *g_mem, *w_mem_kv, *g_grp, *w_out, *g_ffn2, *w_ffn2_up, *w_ffn2_down, *g_final;
              float* out; unsigned char* ws; int ph_lo, ph_hi, coop, dup; };

__device__ __forceinline__ void prologue(const Args& a, LAS unsigned char* lds, int gw, int NGW, int wave, int lane) {
    LAS float* scr = (LAS float*)(lds + wave * 16384);
    unsigned char* ws = a.ws;
    constexpr int I_UP = 16 * 176, I_DN = 44 * 32, I_IN = 16 * 56, I_OUT = 16 * 32, I_MEM = 16 * 8;
    constexpr int I_LAYER = 2 * I_UP + 2 * I_DN + I_IN + I_OUT + 2 * I_MEM;
    for (int it = gw; it < 2 * I_LAYER; it += NGW) {
        const int l = it >= I_LAYER ? 1 : 0; int r = it - l * I_LAYER;
        unsigned char* wl = ws + WS_W0 + (size_t)l * WS_WL;
        if (r < I_UP) { tr_item(a.w_ffn1_up + (size_t)l * DM * 2 * DFF, 2 * DFF, DM, a.g_ffn1 + l * DM, (bf16*)(wl + OFF_WUP1), r, 176, 1, 0, scr, lane); continue; } r -= I_UP;
        if (r < I_UP) { tr_item(a.w_ffn2_up + (size_t)l * DM * 2 * DFF, 2 * DFF, DM, a.g_ffn2 + l * DM, (bf16*)(wl + OFF_WUP2), r, 176, 1, 0, scr, lane); continue; } r -= I_UP;
        if (r < I_DN) { tr_item(a.w_ffn1_down + (size_t)l * DFF * DM, DM, DFF, nullptr, (bf16*)(wl + OFF_WDN1), r, 32, 0, 0, scr, lane); continue; } r -= I_DN;
        if (r < I_DN) { tr_item(a.w_ffn2_down + (size_t)l * DFF * DM, DM, DFF, nullptr, (bf16*)(wl + OFF_WDN2), r, 32, 0, 0, scr, lane); continue; } r -= I_DN;
        if (r < I_IN) { tr_item(a.w_in + (size_t)l * DM * DIN, DIN, DM, a.g_mix + l * DM, (bf16*)(wl + OFF_WIN), r, 56, 0, 0, scr, lane); continue; } r -= I_IN;
        if (r < I_OUT) { tr_item(a.w_out + (size_t)l * DM * DM, DM, DM, a.g_grp + l * DM, (bf16*)(wl + OFF_WOUT), r, 32, 0, 0, scr, lane); continue; } r -= I_OUT;
        if (r < I_MEM) { tr_item(a.w_mem_kv + (size_t)l * DM * 512, 512, DM, a.g_mem + l * DM, (bf16*)(ws + WS_WMK), r, 8, 0, l * 256, scr, lane); continue; } r -= I_MEM;
        tr_item(a.w_mem_kv + (size_t)l * DM * 512 + 256, 512, DM, a.g_mem + l * DM, (bf16*)(ws + WS_WMV), r, 8, 0, l * 256, scr, lane);
    }
    bf16* hb = (bf16*)(ws + WS_HB); float* ss = (float*)(ws + WS_SS);
    for (int m0 = gw; m0 < NTOK; m0 += 2 * NGW) {
        f32x4 v[2][4]; float s[2] = {0.f, 0.f};
#pragma unroll
        for (int q = 0; q < 2; ++q) { const int mr = (m0 + q * NGW < NTOK) ? m0 + q * NGW : m0; const f32x4* xr = (const f32x4*)(a.x + (size_t)mr * DM) + lane;
#pragma unroll
            for (int j = 0; j < 4; ++j) v[q][j] = xr[64 * j]; }
#pragma unroll
        for (int q = 0; q < 2; ++q) { const int m = m0 + q * NGW; if (m >= NTOK) break;
#pragma unroll
            for (int j = 0; j < 4; ++j) s[q] += (v[q][j].x * v[q][j].x + v[q][j].y * v[q][j].y) + (v[q][j].z * v[q][j].z + v[q][j].w * v[q][j].w);
            const float tot = wave_sum(s[q]);
            u32x2* o8 = (u32x2*)(hb + (size_t)m * DM) + lane;
#pragma unroll
            for (int j = 0; j < 4; ++j) { u32x2 o; o.x = cvtpk(v[q][j].x, v[q][j].y); o.y = cvtpk(v[q][j].z, v[q][j].w); o8[64 * j] = o; }
            if (lane < 16) ss[(size_t)m * 16 + lane] = lane == 0 ? tot : 0.f; }
    }
    bf16* memn = (bf16*)(ws + WS_MEMN); bf16* memnp = (bf16*)(ws + WS_MEMNP);
    for (int m = gw; m < NMEM; m += NGW) {
        const f32x4* xr = (const f32x4*)(a.mem + (size_t)m * DM) + lane; f32x4 v[4]; float s = 0.f;
#pragma unroll
        for (int j = 0; j < 4; ++j) { v[j] = xr[64 * j]; s += (v[j].x * v[j].x + v[j].y * v[j].y) + (v[j].z * v[j].z + v[j].w * v[j].w); }
        const float rstd = __builtin_amdgcn_rsqf(wave_sum(s) * (1.0f / DM) + EPS);
        const int kk = m & 15, mp = (m & ~15) + 8 * ((kk >> 2) & 1) + 4 * ((kk >> 3) & 1) + (kk & 3);
        u32x2* o8 = (u32x2*)(memn + (size_t)m * DM) + lane; u32x2* p8 = (u32x2*)(memnp + (size_t)mp * DM) + lane;
#pragma unroll
        for (int j = 0; j < 4; ++j) { u32x2 o; o.x = cvtpk(v[j].x * rstd, v[j].y * rstd); o.y = cvtpk(v[j].z * rstd, v[j].w * rstd); o8[64 * j] = o; p8[64 * j] = o; }
    }
}

__device__ __forceinline__ void final_norm(const Args& a, int gw, int NGW, int lane) {
    const float* ss = (const float*)(a.ws + WS_SS); const bf16* hb = (const bf16*)(a.ws + WS_HB);
    f32x4 gv[4];
#pragma unroll
    for (int j = 0; j < 4; ++j) gv[j] = ((const f32x4*)a.g_final)[64 * j + lane];
    for (int m0 = gw; m0 < NTOK; m0 += 2 * NGW) {
        f32x4 p[2][4]; u32x2 hv[2][4];
#pragma unroll
        for (int q = 0; q < 2; ++q) { const int m = (m0 + q * NGW < NTOK) ? m0 + q * NGW : m0; const f32x4* sp = (const f32x4*)(ss + (size_t)m * 16); const u32x2* hr = (const u32x2*)(hb + (size_t)m * DM) + lane;
#pragma unroll
            for (int j = 0; j < 4; ++j) { p[q][j] = sp[j]; hv[q][j] = hr[64 * j]; } }
#pragma unroll
        for (int q = 0; q < 2; ++q) { const int m = m0 + q * NGW; if (m >= NTOK) break;
            const float sm = (((p[q][0].x + p[q][0].y) + (p[q][0].z + p[q][0].w)) + ((p[q][1].x + p[q][1].y) + (p[q][1].z + p[q][1].w))) + (((p[q][2].x + p[q][2].y) + (p[q][2].z + p[q][2].w)) + ((p[q][3].x + p[q][3].y) + (p[q][3].z + p[q][3].w)));
            const float r = __builtin_amdgcn_rsqf(sm * (1.0f / 1024.0f) + EPS);
            f32x4* xr = (f32x4*)(a.out + (size_t)m * DM) + lane;
#pragma unroll
            for (int j = 0; j < 4; ++j) { f32x4 v;
                v.x = __uint_as_float(hv[q][j].x << 16); v.y = __uint_as_float(hv[q][j].x & 0xffff0000u); v.z = __uint_as_float(hv[q][j].y << 16); v.w = __uint_as_float(hv[q][j].y & 0xffff0000u);
                xr[64 * j] = v * r * gv[j]; } }
    }
}

__device__ __forceinline__ int crow(int i, int h) { return (i & 3) + 8 * (i >> 2) + 4 * h; }
__device__ __forceinline__ bf16x8 pack8(const f32x16& s, int o) {
    u32x4 w; w.x = cvtpk(s[o + 0], s[o + 1]); w.y = cvtpk(s[o + 2], s[o + 3]); w.z = cvtpk(s[o + 4], s[o + 5]); w.w = cvtpk(s[o + 6], s[o + 7]);
    return __builtin_bit_cast(bf16x8, w);
}
__device__ __forceinline__ f32x16 zero16() { f32x16 z;
#pragma unroll
    for (int i = 0; i < 16; ++i) z[i] = 0.f;
    return z; }
typedef short v4i16_t __attribute__((ext_vector_type(4)));
__device__ __forceinline__ s16x4 vtr(LAS unsigned char* p) { return __builtin_bit_cast(s16x4, __builtin_amdgcn_ds_read_tr16_b64_v4i16((LAS v4i16_t*)p)); }
__device__ __forceinline__ void store_ot(bf16* dst, const f32x16& o0, const f32x16& o1, float rs, int h) {
#pragma unroll
    for (int g = 0; g < 4; ++g) {
        u32x2 w0; w0.x = cvtpk(o0[4 * g] * rs, o0[4 * g + 1] * rs); w0.y = cvtpk(o0[4 * g + 2] * rs, o0[4 * g + 3] * rs);
        u32x2 w1; w1.x = cvtpk(o1[4 * g] * rs, o1[4 * g + 1] * rs); w1.y = cvtpk(o1[4 * g + 2] * rs, o1[4 * g + 3] * rs);
        *(u32x2*)(dst + 8 * g + 4 * h) = w0; *(u32x2*)(dst + 32 + 8 * g + 4 * h) = w1;
    }
}
__device__ __forceinline__ void pack_ot(u32x4 (&pk)[4], const f32x16& o0, const f32x16& o1) {
#pragma unroll
    for (int g2 = 0; g2 < 2; ++g2) {
        pk[g2].x = cvtpk(o0[8 * g2], o0[8 * g2 + 1]); pk[g2].y = cvtpk(o0[8 * g2 + 2], o0[8 * g2 + 3]); pk[g2].z = cvtpk(o0[8 * g2 + 4], o0[8 * g2 + 5]); pk[g2].w = cvtpk(o0[8 * g2 + 6], o0[8 * g2 + 7]);
        pk[2 + g2].x = cvtpk(o1[8 * g2], o1[8 * g2 + 1]); pk[2 + g2].y = cvtpk(o1[8 * g2 + 2], o1[8 * g2 + 3]); pk[2 + g2].z = cvtpk(o1[8 * g2 + 4], o1[8 * g2 + 5]); pk[2 + g2].w = cvtpk(o1[8 * g2 + 6], o1[8 * g2 + 7]); }
}
__device__ __forceinline__ void store_pk(bf16* dst, const u32x4 (&pk)[4], float rs, int h) {
#pragma unroll
    for (int i = 0; i < 4; ++i) { float f[8]; unpack8(pk[i], f); const int dt = i >> 1, g0 = 2 * (i & 1);
        u32x2 w0; w0.x = cvtpk(f[0] * rs, f[1] * rs); w0.y = cvtpk(f[2] * rs, f[3] * rs);
        u32x2 w1; w1.x = cvtpk(f[4] * rs, f[5] * rs); w1.y = cvtpk(f[6] * rs, f[7] * rs);
        *(u32x2*)(dst + 32 * dt + 8 * g0 + 4 * h) = w0; *(u32x2*)(dst + 32 * dt + 8 * (g0 + 1) + 4 * h) = w1; }
}
__device__ __forceinline__ void store_pk_lds(LAS unsigned char* wbuf, bf16* gbase, const u32x4 (&pk)[4], float rs, int r, int h, int lane) {
#pragma unroll
    for (int i = 0; i < 4; ++i) { float f[8]; unpack8(pk[i], f); const int c0 = 4 * (i >> 1) + 2 * (i & 1);
        u32x2 w0; w0.x = cvtpk(f[0] * rs, f[1] * rs); w0.y = cvtpk(f[2] * rs, f[3] * rs);
        u32x2 w1; w1.x = cvtpk(f[4] * rs, f[5] * rs); w1.y = cvtpk(f[6] * rs, f[7] * rs);
        *(LAS u32x2*)(wbuf + r * 128 + ((c0 ^ (r & 7)) << 4) + 8 * h) = w0; *(LAS u32x2*)(wbuf + r * 128 + (((c0 + 1) ^ (r & 7)) << 4) + 8 * h) = w1; }
#pragma unroll
    for (int k = 0; k < 4; ++k) { const int row = (lane >> 3) + 8 * k, pc = lane & 7, lc = pc ^ (row & 7);
        const u32x4 v = *(const LAS u32x4*)(wbuf + row * 128 + pc * 16);
        *(u32x4*)(gbase + (size_t)row * DM + 8 * lc) = v; }
}
__device__ __forceinline__ float sumsq16(const f32x16& o) { float s = 0.f;
#pragma unroll
    for (int i = 0; i < 16; ++i) s += o[i] * o[i];
    return s; }

__device__ __forceinline__ void mixer_phase(LAS unsigned char* lds, const bf16* __restrict__ P, const bf16* __restrict__ MK, const bf16* __restrict__ VT, const float* __restrict__ convw,
                                            const float* __restrict__ sinks, bf16* __restrict__ mixed, int layer, int G, int bid, const int tid_arg, const int var) {
    const int tid_in = tid_arg;
    LAS float* ssqS = (LAS float*)(lds + 98304);
    LAS float* ssqM = (LAS float*)(lds + 98304 + 2048);
    LAS float* rsT = (LAS float*)(lds + 98304 + 3072);
    for (int u = bid; u < 512; u += G) {
        int tid = tid_in; asm volatile("" : "+v"(tid));
        const int lane = tid & 63, w = __builtin_amdgcn_readfirstlane(tid >> 6), r = lane & 31, h = lane >> 5;
        const int b = u >> 6, q0 = (u & 63) * 64; const size_t tok0 = (size_t)b * SEQ + q0;
        if (!(var & 8)) {
#pragma unroll
            for (int ps = 0; ps < 12; ++ps) {
                const int blk = ps * 8 + w, isV = blk >= 48 ? 1 : 0, kb = blk - 48 * isV, kvh = kb >= 24 ? 1 : 0, key = 8 * (kb - 24 * kvh) + (lane >> 3), s16 = lane & 7;
                const int c8 = isV ? ((((s16 >> 2) ^ ((key >> 1) & 1)) << 2) | (s16 & 3)) : (s16 ^ ((key >> 1) & 7));
                int pos = q0 - 128 + key; pos = pos < 0 ? 0 : pos;
                const bf16* src = P + ((size_t)b * SEQ + pos) * DIN + 1280 + isV * 128 + kvh * 64 + c8 * 8;
                __builtin_amdgcn_global_load_lds((const unsigned*)src, (LAS unsigned*)(lds + blk * 1024), 16, 0, 0);
            }
        }
        if (!(var & 1)) {
            const int c8 = tid & 31, tg = tid >> 5, c0 = c8 * 8, t0 = 4 * tg;
            float w0[8], w1[8], w2[8];
            { const f32x4 a0 = *(const f32x4*)(convw + c0), a1 = *(const f32x4*)(convw + c0 + 4), b0 = *(const f32x4*)(convw + 256 + c0), b1 = *(const f32x4*)(convw + 256 + c0 + 4),
                          d0 = *(const f32x4*)(convw + 512 + c0), d1 = *(const f32x4*)(convw + 512 + c0 + 4);
#pragma unroll
              for (int j = 0; j < 4; ++j) { w0[j] = a0[j]; w0[4 + j] = a1[j]; w1[j] = b0[j]; w1[4 + j] = b1[j]; w2[j] = d0[j]; w2[4 + j] = d1[j]; } }
            const bool halo = (q0 + t0 - 2 >= 0); const size_t th = halo ? (tok0 + t0 - 2) : tok0;
            u32x4 rh[2][2], rt[4][3];
#pragma unroll
            for (int i = 0; i < 2; ++i) { const bf16* pp = P + (th + i) * DIN + c0; rh[i][0] = *(const u32x4*)(pp + 256); rh[i][1] = *(const u32x4*)(pp + 512); }
#pragma unroll
            for (int i = 0; i < 4; ++i) { const bf16* pp = P + (tok0 + t0 + i) * DIN + c0; rt[i][0] = *(const u32x4*)(pp); rt[i][1] = *(const u32x4*)(pp + 256); rt[i][2] = *(const u32x4*)(pp + 512); }
            float vm2[8], vm1[8];
            { float cg_[8], uu[8]; const float hz = halo ? 1.0f : 0.0f;
              unpack8(rh[0][0], cg_); unpack8(rh[0][1], uu);
#pragma unroll
              for (int j = 0; j < 8; ++j) vm2[j] = cg_[j] * uu[j] * hz;
              unpack8(rh[1][0], cg_); unpack8(rh[1][1], uu);
#pragma unroll
              for (int j = 0; j < 8; ++j) vm1[j] = cg_[j] * uu[j] * hz; }
#pragma unroll
            for (int i = 0; i < 4; ++i) {
                float bg[8], cg_[8], uu[8], y[8];
                unpack8(rt[i][0], bg); unpack8(rt[i][1], cg_); unpack8(rt[i][2], uu);
                float sq = 0.f;
#pragma unroll
                for (int j = 0; j < 8; ++j) { const float v = cg_[j] * uu[j]; y[j] = bg[j] * (w0[j] * vm2[j] + w1[j] * vm1[j] + w2[j] * v); vm2[j] = vm1[j]; vm1[j] = v; sq += y[j] * y[j]; }
#pragma unroll
                for (int o = 1; o < 32; o <<= 1) sq += __shfl_xor(sq, o);
                const float rs = __builtin_amdgcn_rsqf(sq * (1.0f / 256.0f) + EPS);
                u32x4 wv; wv.x = cvtpk(y[0] * rs, y[1] * rs); wv.y = cvtpk(y[2] * rs, y[3] * rs); wv.z = cvtpk(y[4] * rs, y[5] * rs); wv.w = cvtpk(y[6] * rs, y[7] * rs);
                *(u32x4*)(mixed + (tok0 + t0 + i) * DM + c0) = wv;
            }
        }
        asm volatile("s_waitcnt vmcnt(0)" ::: "memory");
        __syncthreads();
        u32x4 HM[4] = {};
        u32x4 HS[2][4] = {};
#pragma unroll 1
        for (int step = 0; step < 2; ++step) {
        if ((step == 0) == (w < 4)) {
        if (!(var & 2)) {
            const int hm = w >> 1, qt = w & 1;
            const bf16* qp = P + (tok0 + 32 * qt + r) * DIN + 1536 + hm * 64 + 8 * h;
            bf16x8 qf[4];
#pragma unroll
            for (int ks = 0; ks < 4; ++ks) qf[ks] = *(const bf16x8*)(qp + 16 * ks);
            const bf16* kp = MK + (size_t)(b * MEML + r) * 512 + layer * 256 + hm * 64 + 8 * h;
            const bf16* vp = VT + (size_t)(layer * 256 + hm * 64 + r) * NMEM + b * MEML + 8 * h;
            const float c = 0.125f * LOG2E;
            f32x16 o0 = zero16(), o1 = zero16(); float mrun = -INFINITY, lrun = 0.f;
#pragma unroll 1
            for (int hf = 0; hf < 2; ++hf) {
                f32x16 S[4];
#pragma unroll
                for (int jp = 0; jp < 2; ++jp) {
                    bf16x8 kf[2][4];
#pragma unroll
                    for (int j2 = 0; j2 < 2; ++j2)
#pragma unroll
                        for (int ks = 0; ks < 4; ++ks) kf[j2][ks] = *(const bf16x8*)(kp + (size_t)(4 * hf + 2 * jp + j2) * 32 * 512 + 16 * ks);
                    __builtin_amdgcn_sched_barrier(0);
#pragma unroll
                    for (int j2 = 0; j2 < 2; ++j2) { S[2 * jp + j2] = zero16();
#pragma unroll
                        for (int ks = 0; ks < 4; ++ks) S[2 * jp + j2] = __builtin_amdgcn_mfma_f32_32x32x16_bf16(kf[j2][ks], qf[ks], S[2 * jp + j2], 0, 0, 0); }
                    __builtin_amdgcn_sched_barrier(0);
                }
                float mx = mrun;
#pragma unroll
                for (int jt = 0; jt < 4; ++jt)
#pragma unroll
                    for (int i = 0; i < 16; ++i) mx = fmaxf(mx, S[jt][i] * c);
                mx = xmax32(mx);
                const float alpha = __builtin_amdgcn_exp2f(mrun - mx);
                float sum = 0.f;
#pragma unroll
                for (int jt = 0; jt < 4; ++jt)
#pragma unroll
                    for (int i = 0; i < 16; ++i) { const float p = __builtin_amdgcn_exp2f(S[jt][i] * c - mx); S[jt][i] = p; sum += p; }
                sum = xsum32(sum);
                lrun = lrun * alpha + sum; mrun = mx;
                o0 = o0 * alpha; o1 = o1 * alpha;
#pragma unroll
                for (int jp = 0; jp < 2; ++jp) {
                    bf16x8 vf[2][2][2];
#pragma unroll
                    for (int j2 = 0; j2 < 2; ++j2)
#pragma unroll
                        for (int s = 0; s < 2; ++s) { const int ko = 32 * (4 * hf + 2 * jp + j2) + 16 * s; vf[j2][s][0] = *(const bf16x8*)(vp + ko); vf[j2][s][1] = *(const bf16x8*)(vp + (size_t)32 * NMEM + ko); }
                    __builtin_amdgcn_sched_barrier(0);
#pragma unroll
                    for (int j2 = 0; j2 < 2; ++j2)
#pragma unroll
                        for (int s = 0; s < 2; ++s) { const bf16x8 pb = pack8(S[2 * jp + j2], 8 * s);
                            o0 = __builtin_amdgcn_mfma_f32_32x32x16_bf16(vf[j2][s][0], pb, o0, 0, 0, 0); o1 = __builtin_amdgcn_mfma_f32_32x32x16_bf16(vf[j2][s][1], pb, o1, 0, 0, 0); }
                    __builtin_amdgcn_sched_barrier(0);
                }
            }
            const float inv = __builtin_amdgcn_rcpf(lrun);
            o0 = o0 * inv; o1 = o1 * inv;
            float sq = sumsq16(o0) + sumsq16(o1); sq = xsum32(sq);
            if (h == 0) ssqM[hm * 64 + 32 * qt + r] = sq;
            pack_ot(HM, o0, o1);
            __builtin_amdgcn_sched_barrier(0);
        }
        } else {
        if (!(var & 4)) {
            const int kvh = w >> 2;
            const float slope2 = __builtin_amdgcn_exp2f(-(float)(w + 1)) * LOG2E, sink2 = sinks[w] * LOG2E, c = 0.125f * LOG2E;
            const int sjmin = 128 - q0;
            LAS unsigned char* Kb = lds + kvh * 24576;
            const int qq = (lane & 15) >> 2, xh = (qq >> 1) & 1;
            LAS unsigned char* Vb = lds + 49152 + kvh * 24576 + (4 * h + qq) * 128 + ((2 * ((lane >> 4) & 1) + ((lane & 3) >> 1)) << 4) + 8 * (lane & 1);
            LAS unsigned char* Vb0 = Vb + (xh << 6); LAS unsigned char* Vb1 = Vb + ((xh ^ 1) << 6);
#pragma unroll
            for (int qt = 0; qt < 2; ++qt) {
                const bf16* qp = P + (tok0 + 32 * qt + r) * DIN + 768 + w * 64 + 8 * h;
                bf16x8 qf[4];
#pragma unroll
                for (int ks = 0; ks < 4; ++ks) qf[ks] = *(const bf16x8*)(qp + 16 * ks);
                f32x16 S[5];
#pragma unroll
                for (int tp = 0; tp < 3; ++tp) {
                    bf16x8 kf[2][4];
#pragma unroll
                    for (int j2 = 0; j2 < 2; ++j2) { const int t5 = 2 * tp + j2; if (t5 < 5) { const int key = 32 * (qt + t5) + r;
#pragma unroll
                        for (int ks = 0; ks < 4; ++ks) kf[j2][ks] = *(const LAS bf16x8*)(Kb + key * 128 + (((2 * ks + h) ^ ((key >> 1) & 7)) << 4)); } }
                    __builtin_amdgcn_sched_barrier(0);
#pragma unroll
                    for (int j2 = 0; j2 < 2; ++j2) { const int t5 = 2 * tp + j2; if (t5 < 5) { S[t5] = zero16();
#pragma unroll
                        for (int ks = 0; ks < 4; ++ks) S[t5] = __builtin_amdgcn_mfma_f32_32x32x16_bf16(kf[j2][ks], qf[ks], S[t5], 0, 0, 0); } }
                    __builtin_amdgcn_sched_barrier(0);
                }
                const int qi = 32 * qt + r; float mx = sink2;
                int hq = h; asm volatile("" : "+v"(hq));
#pragma unroll
                for (int t5 = 0; t5 < 5; ++t5)
#pragma unroll
                    for (int i = 0; i < 16; ++i) { const int sj = 32 * (qt + t5) + crow(i, hq), dist = qi + 128 - sj; const bool ok = (dist >= 0) && (dist < 128) && (sj >= sjmin);
                        const float v = ok ? S[t5][i] * c - slope2 * (float)dist : -INFINITY; S[t5][i] = v; mx = fmaxf(mx, v); }
                mx = xmax32(mx);
                float sum = 0.f;
#pragma unroll
                for (int t5 = 0; t5 < 5; ++t5)
#pragma unroll
                    for (int i = 0; i < 16; ++i) { const float p = __builtin_amdgcn_exp2f(S[t5][i] - mx); S[t5][i] = p; sum += p; }
                sum = xsum32(sum); sum += __builtin_amdgcn_exp2f(sink2 - mx);
                f32x16 o0 = zero16(), o1 = zero16();
#pragma unroll
                for (int t5 = 0; t5 < 5; ++t5) {
                    s16x4 tv[2][4];
#pragma unroll
                    for (int s = 0; s < 2; ++s) { const int ko = (32 * (qt + t5) + 16 * s) * 128; tv[s][0] = vtr(Vb0 + ko); tv[s][1] = vtr(Vb0 + ko + 8 * 128); tv[s][2] = vtr(Vb1 + ko); tv[s][3] = vtr(Vb1 + ko + 8 * 128); }
                    __builtin_amdgcn_sched_barrier(0);
#pragma unroll
                    for (int s = 0; s < 2; ++s) { const bf16x8 pb = pack8(S[t5], 8 * s);
                        const bf16x8 v0 = {tv[s][0][0], tv[s][0][1], tv[s][0][2], tv[s][0][3], tv[s][1][0], tv[s][1][1], tv[s][1][2], tv[s][1][3]}, v1 = {tv[s][2][0], tv[s][2][1], tv[s][2][2], tv[s][2][3], tv[s][3][0], tv[s][3][1], tv[s][3][2], tv[s][3][3]};
                        o0 = __builtin_amdgcn_mfma_f32_32x32x16_bf16(v0, pb, o0, 0, 0, 0); o1 = __builtin_amdgcn_mfma_f32_32x32x16_bf16(v1, pb, o1, 0, 0, 0); }
                    __builtin_amdgcn_sched_barrier(0);
                }
                const float inv = __builtin_amdgcn_rcpf(sum);
                o0 = o0 * inv; o1 = o1 * inv;
                float sq = sumsq16(o0) + sumsq16(o1); sq = xsum32(sq);
                if (h == 0) ssqS[w * 64 + qi] = sq;
                pack_ot(HS[qt], o0, o1);
                __builtin_amdgcn_sched_barrier(0);
            }
        }
        }
        }
        __syncthreads();
        if (!(var & 16)) {
            const int hm = w >> 1, qm = 32 * (w & 1) + r;
            const float totm = (ssqM[qm] + ssqM[64 + qm]) + (ssqM[128 + qm] + ssqM[192 + qm]);
            LAS unsigned char* wb = lds + w * 12288;
            store_pk_lds(wb, mixed + (tok0 + 32 * (w & 1)) * DM + 768 + hm * 64, HM, __builtin_amdgcn_rsqf(totm * (1.0f / 256.0f) + EPS), r, h, lane);
#pragma unroll
            for (int qt = 0; qt < 2; ++qt) { const int q = 32 * qt + r; float tot = 0.f;
#pragma unroll
                for (int hh = 0; hh < 8; ++hh) tot += ssqS[hh * 64 + q];
                store_pk_lds(wb + 4096 * (qt + 1), mixed + (tok0 + 32 * qt) * DM + 256 + w * 64, HS[qt], __builtin_amdgcn_rsqf(tot * (1.0f / 512.0f) + EPS), r, h, lane); }
        }
        __syncthreads();
    }
}


#define XB_TMO      128
#define XB_XCNT(j)  (256  + 64 * (j))
#define XB_XSUB(j)  (1280 + 64 * (j))
#define XB_XGEN(j)  (2304 + 64 * (j))
#define XB_TOP      3328
#define XB_TOPGEN   3392
#define XCD_BAR_WORDS 3456
#define XB_SPIN_CAP (1u << 18)

__device__ __forceinline__ unsigned xb_ld(unsigned* p)              { return __hip_atomic_load(p, __ATOMIC_RELAXED, __HIP_MEMORY_SCOPE_AGENT); }
__device__ __forceinline__ unsigned xb_add(unsigned* p, unsigned v) { return __hip_atomic_fetch_add(p, v, __ATOMIC_RELAXED, __HIP_MEMORY_SCOPE_AGENT); }
__device__ __forceinline__ unsigned xb_xcc_id() { return (unsigned)__builtin_amdgcn_s_getreg((3 << 11) | 20) & 0xFu; }
#define XB_SPIN(cond, bar) do { unsigned _sp = 0; while (cond) { __builtin_amdgcn_s_sleep(1); \
    if ((++_sp & 255u) == 0u) { if (xb_ld(&(bar)[XB_TMO])) break; if (_sp > XB_SPIN_CAP) { atomicAdd(&(bar)[XB_TMO], 1u); break; } } } } while (0)

struct XcdBarrier {
    unsigned* bar; unsigned x;
    volatile LAS unsigned* st;
};

__device__ __forceinline__ XcdBarrier xcd_barrier_post(unsigned* bar, volatile LAS unsigned* st) {
    XcdBarrier b; b.bar = bar; b.x = xb_xcc_id(); b.st = st;
    if (threadIdx.x == 0) (void)xb_add(&bar[XB_XCNT(b.x)], 1u);
    return b;
}
__device__ __forceinline__ void xcd_barrier_complete(unsigned* bar, unsigned x, unsigned& nloc, unsigned& nx) {
    const unsigned G = gridDim.x * gridDim.y * gridDim.z;
    unsigned sum, cnt, mine, sp = 0u;
    for (;;) {
        sum = 0u; cnt = 0u; mine = 0u;
#pragma unroll
        for (unsigned j = 0; j < 16; ++j) { const unsigned c = xb_ld(&bar[XB_XCNT(j)]); sum += c; cnt += (c > 0u) ? 1u : 0u; mine = (j == x) ? c : mine; }
        if (sum == G) break;
        __builtin_amdgcn_s_sleep(1);
        if ((++sp & 255u) == 0u) { if (xb_ld(&bar[XB_TMO])) break; if (sp > XB_SPIN_CAP) { atomicAdd(&bar[XB_TMO], 1u); break; } }
    }
    nloc = mine > 0u ? mine : 1u; nx = cnt > 0u ? cnt : 1u;
}

__device__ __forceinline__ void xcd_barrier(const XcdBarrier& b) {
    asm volatile("s_waitcnt vmcnt(0)" ::: "memory");
    __syncthreads();
    if (threadIdx.x == 0) {
        unsigned* bar = b.bar;
        __builtin_amdgcn_s_waitcnt(0);
        unsigned nloc = b.st[0], nx = b.st[1];
        if (nloc == 0u) { xcd_barrier_complete(bar, b.x, nloc, nx); b.st[0] = nloc; b.st[1] = nx; }
        const unsigned old = xb_add(&bar[XB_XSUB(b.x)], 1u);
        const unsigned gen = old / nloc;
        if (old + 1u == (gen + 1u) * nloc) {
            __builtin_amdgcn_fence(__ATOMIC_RELEASE, "agent");
            asm volatile("s_waitcnt vmcnt(0)" ::: "memory");
            const unsigned og = xb_add(&bar[XB_TOP], 1u);
            const unsigned tg = og / nx;
            if (og + 1u == (tg + 1u) * nx) xb_add(&bar[XB_TOPGEN], 1u);
            else XB_SPIN(xb_ld(&bar[XB_TOPGEN]) == tg, bar);
            __builtin_amdgcn_fence(__ATOMIC_ACQUIRE, "agent");
            xb_add(&bar[XB_XGEN(b.x)], 1u);
            asm volatile("s_waitcnt vmcnt(0)" ::: "memory");
        } else {
            XB_SPIN(xb_ld(&bar[XB_XGEN(b.x)]) == gen, bar);
            __builtin_amdgcn_fence(__ATOMIC_ACQUIRE, "agent");
            asm volatile("s_waitcnt vmcnt(0)" ::: "memory");
        }
    }
    __syncthreads();
}


__global__ void __launch_bounds__(512) fwd_kernel(Args a) {
    extern __shared__ __attribute__((aligned(16))) unsigned char lds_raw[];
    LAS unsigned char* lds = (LAS unsigned char*)lds_raw;
    if (threadIdx.x < 16) ((LAS unsigned*)(lds + LDS_BARW))[threadIdx.x] = 0u;
    __syncthreads();
    XcdBarrier bar; bar.bar = (unsigned*)(a.ws + WS_CTL); bar.x = 0; bar.st = nullptr;
    if (a.coop) bar = xcd_barrier_post((unsigned*)(a.ws + WS_CTL), (volatile LAS unsigned*)(lds + LDS_BARW));
    int ph0 = a.ph_lo;
    if (ph0 == 0) {
        int tid = threadIdx.x; asm volatile("" : "+v"(tid));
        const int lane = tid & 63, wave = __builtin_amdgcn_readfirstlane(tid >> 6), gw = (int)blockIdx.x * 8 + wave, NGW = (int)gridDim.x * 8;
        prologue(a, lds, gw, NGW, wave, lane);
        ph0 = 1;
        if (ph0 < a.ph_hi) { if (a.coop == 2) cg::this_grid().sync(); else if (a.coop) xcd_barrier(bar); else __syncthreads(); }
    }
    for (int ph = ph0; ph < a.ph_hi; ++ph) {
      const int reps = 1 + MK_DUPN * ((a.dup >> ph) & 1);
      for (int rep = 0; rep < reps; ++rep) {
        if (MK_STAG > 0 && (ph == 1 || ph == 6 || ph == 8 || ph == 13 || (MK_STAGR && (ph == 2 || ph == 5 || ph == 7 || ph == 9 || ph == 12 || ph == 14))) && (blockIdx.x & 1)) {
#pragma unroll 1
            for (int i = 0; i < MK_STAG; ++i) __builtin_amdgcn_s_sleep(127); }
        int tid = threadIdx.x; asm volatile("" : "+v"(tid));
        int G = gridDim.x, bid = blockIdx.x; asm volatile("" : "+s"(G), "+s"(bid));
        size_t wz = 0; asm volatile("" : "+s"(wz));
        unsigned char* ws = a.ws + wz;
        const int lane = tid & 63, wave = __builtin_amdgcn_readfirstlane(tid >> 6), gw = bid * 8 + wave, NGW = G * 8;
        float* ss = (float*)(ws + WS_SS); bf16* hb = (bf16*)(ws + WS_HB); bf16* act = (bf16*)(ws + WS_ACT); bf16* Pb = (bf16*)(ws + WS_P); bf16* mixed = (bf16*)(ws + WS_MIXED);
        if (ph == NPHASE - 1) final_norm(a, gw, NGW, lane);
        else {
            const int l = (ph - 1) / 7, s = (ph - 1) % 7;
            unsigned char* wl = ws + WS_W0 + (size_t)l * WS_WL;
            if (s == 0 || s == 5) {
                pg8::Gemm g{hb, (const bf16*)(wl + (s == 0 ? OFF_WUP1 : OFF_WUP2)), NTOK, 2 * DFF, DM}; pg8::StaticOrder S; S.init(NTOK, 2 * DFF, G, bid);
                EpiSwiglu E{act, ss, (rep + 1 < reps) ? MK_SKIPEPI : 0};
                pg8::gemm_phase<EpiSwiglu, pg8::StaticOrder, true, true>(lds, g, S, E, tid);
            } else if (s == 1 || s == 4 || s == 6) {
                const bool isout = (s == 4);
                pg8::Gemm g{isout ? mixed : act, (const bf16*)(wl + (s == 1 ? OFF_WDN1 : (s == 4 ? OFF_WOUT : OFF_WDN2))), NTOK, DM, isout ? DM : DFF}; pg8::StaticOrder S; S.init(NTOK, DM, G, bid); S.rev = MK_REV;
                EpiResid E{hb, ss, isout ? 1.0f : 0.5f};
                pg8::gemm_phase<EpiResid, pg8::StaticOrder, true, true>(lds, g, S, E, tid);
            } else if (s == 2) {
                const int ng = (l == 0) ? 3 : 1;
                if (MK_WSTAG > 0 && G == 256 && bid >= (l == 0 ? 160 : 128)) {
#pragma unroll 1
                    for (int i = 0; i < MK_WSTAG; ++i) __builtin_amdgcn_s_sleep(127); }
                for (int gi = 0; gi < ng; ++gi) {
                    pg8::Gemm g; pg8::StaticOrder S; EpiScaleBf16 E;
                    if (gi == 0) { g = pg8::Gemm{hb, (const bf16*)(wl + OFF_WIN), NTOK, DIN, DM}; S.init(NTOK, DIN, G, bid); E = EpiScaleBf16{Pb, DIN, ss}; }
                    else if (gi == 1) { g = pg8::Gemm{(const bf16*)(ws + WS_MEMN), (const bf16*)(ws + WS_WMK), NMEM, 512, DM}; S.init(NMEM, 512, G, (bid + 128) % G); E = EpiScaleBf16{(bf16*)(ws + WS_MK), 512, nullptr}; }
                    else { g = pg8::Gemm{(const bf16*)(ws + WS_WMV), (const bf16*)(ws + WS_MEMNP), 512, NMEM, DM}; S.init(512, NMEM, G, (bid + 112) % G); E = EpiScaleBf16{(bf16*)(ws + WS_VT), NMEM, nullptr}; }
                    pg8::gemm_phase<EpiScaleBf16, pg8::StaticOrder, false, true>(lds, g, S, E, tid);
                }
            } else {
                mixer_phase(lds, Pb, (const bf16*)(ws + WS_MK), (const bf16*)(ws + WS_VT), a.conv_w + l * 768, a.sinks + l * 8, mixed, l, G, bid, tid, (rep + 1 < reps) ? MK_MIXVAR : 0);
            }
        }
        if (ph + 1 < a.ph_hi || rep + 1 < reps) { if (a.coop == 2) cg::this_grid().sync();
          else if (a.coop) xcd_barrier(bar); else __syncthreads(); }
      }
    }
}

extern "C" void kernel_launch(void* const* d_in, const int* in_sizes, int n_in, void* d_out, int out_size, void* d_ws, size_t ws_size, hipStream_t stream) {
    static int grid = 0;
    if (grid == 0) {
        if (n_in != 17 || in_sizes[0] != NTOK * DM || out_size != NTOK * DM || ws_size < WS_TOTAL) { fprintf(stderr, "kernel_launch: unexpected shapes / workspace (n_in %d, ws %zu)\n", n_in, ws_size); grid = -1; return; }
        int dev = 0, cus = 0, per_cu = 0;
        hipGetDevice(&dev); hipDeviceGetAttribute(&cus, hipDeviceAttributeMultiprocessorCount, dev);
        if (hipFuncSetAttribute((const void*)fwd_kernel, hipFuncAttributeMaxDynamicSharedMemorySize, LDS_BYTES) != hipSuccess) { fprintf(stderr, "kernel_launch: hipFuncSetAttribute failed\n"); grid = -1; return; }
        if (hipOccupancyMaxActiveBlocksPerMultiprocessor(&per_cu, (const void*)fwd_kernel, 512, LDS_BYTES) != hipSuccess || per_cu < 1) { fprintf(stderr, "kernel_launch: occupancy query says %d\n", per_cu); per_cu = 1; }
        (void)hipGetLastError();
        grid = cus * 1;
        if (grid <= 0) grid = 256;
    }
    if (grid < 0) return;
    if (hipMemsetAsync((char*)d_ws + WS_CTL, 0, CTL_BYTES, stream) != hipSuccess) { fprintf(stderr, "kernel_launch: memset of the barrier words failed\n"); return; }
    Args a{};
    const float** ap = (const float**)&a;
    for (int i = 0; i < 17; ++i) ap[i] = (const float*)d_in[i];
    a.out = (float*)d_out; a.ws = (unsigned char*)d_ws;
#if MK_ONE_LAUNCH
    a.ph_lo = 0; a.ph_hi = NPHASE; a.coop = 1; a.dup = MK_DUP;
    void* args[] = {&a};
    hipError_t e = hipLaunchCooperativeKernel((const void*)fwd_kernel, dim3(grid), dim3(512), args, LDS_BYTES, stream);
    if (e != hipSuccess) fprintf(stderr, "cooperative launch failed: %s (grid %d)\n", hipGetErrorString(e), grid);
#else
    for (int ph = 0; ph < NPHASE; ++ph) {
        a.ph_lo = ph; a.ph_hi = ph + 1; a.coop = 0;
        hipLaunchKernelGGL(fwd_kernel, dim3(grid), dim3(512), LDS_BYTES, stream, a);
    }
#endif
}
```

```cpp
#include <hip/hip_runtime.h>
#include <hip/hip_cooperative_groups.h>
#include <cstdio>
#include <cstdint>
namespace cg = cooperative_groups;
#ifndef MK_ONE_LAUNCH
#define MK_ONE_LAUNCH 1
#endif
#ifndef MK_DUP
#define MK_DUP 0
#endif
#ifndef MK_SKIPEPI
#define MK_SKIPEPI 0
#endif
#ifndef MK_MIXVAR
#define MK_MIXVAR 0
#endif
#ifndef MK_DUPN
#define MK_DUPN 1
#endif
#ifndef MK_NST_UP
#define MK_NST_UP 8
#endif
#ifndef MK_NST_RES
#define MK_NST_RES 0
#endif
#ifndef MK_NST_SC
#define MK_NST_SC 0
#endif
#ifndef MK_REV
#define MK_REV 1
#endif

#ifndef MK_FUSE_FINAL
#define MK_FUSE_FINAL 0
#endif

#ifndef MK_DEFER
#define MK_DEFER 0
#endif

#ifndef MK_STAG
#define MK_STAG 3
#endif

#ifndef MK_WSTAG
#define MK_WSTAG 4
#endif

#ifndef MK_STAG4
#define MK_STAG4 1
#endif

#ifndef MK_STAGR
#define MK_STAGR 0
#endif
namespace pg8 {
#define PG8_LAS __attribute__((address_space(3)))
typedef unsigned short bf16_t;
typedef short bf16x8 __attribute__((ext_vector_type(8)));
typedef float f32x4 __attribute__((ext_vector_type(4)));
typedef unsigned u32x4 __attribute__((ext_vector_type(4)));
constexpr int BM = 256, BK = 64, HALF = 128, HTB = HALF * BK * 2  , STAGE_BYTES = 8 * HTB, NXCD = 8, WGM = 8;

__host__ __device__ __forceinline__ int lds_byte(int r, int c) { const int st = (r >> 4) * 2 + (c >> 5), rr = r & 15, cc = c & 31, ob = rr * 64 + cc * 2; return st * 1024 + (ob ^ (((ob >> 9) & 1) << 5)); }
__host__ __device__ __forceinline__ void stage_rc(int b, int& R, int& C) { const int st = b / 1024, sb = b % 1024, swz = sb ^ (((sb >> 9) & 1) << 5); R = (st >> 1) * 16 + swz / 64; C = (st & 1) * 32 + (swz % 64) / 2; }
__host__ __device__ __forceinline__ int perm32(int rho) { const int n = rho >> 4, i = rho & 15; return 8 * (i >> 2) + 4 * n + (i & 3); }

struct Unit { int pm, pn; };
struct Gemm { const bf16_t* A; const bf16_t* Bt; int M, N, K; };

struct StaticOrder {
    int nM, nN, nwg, G, c; int rev = 0;
    __host__ __device__ void init(int M, int N, int G_, int c_) { nM = M / BM; nN = N / BM; nwg = nM * nN; G = G_; c = c_; }
    __host__ __device__ bool next(int i, Unit& u) const {
        const long L = (long)i * G + c; if (L >= nwg) return false;
        int wgid = rev ? (nwg - 1 - (int)L) : (int)L; { const int q = nwg / NXCD, r = nwg % NXCD, xcd = wgid % NXCD, off = wgid / NXCD; wgid = (xcd < r ? xcd * (q + 1) : r * (q + 1) + (xcd - r) * q) + off; }
        const int nig = WGM * nN, gid = wgid / nig, fm = gid * WGM, gsz = (nM - fm) < WGM ? (nM - fm) : WGM;
        u.pm = fm + ((wgid % nig) % gsz); u.pn = (wgid % nig) / gsz; return true;
    }
    __device__ __forceinline__ void a_ready(const Unit&) const {}
    __device__ __forceinline__ void done(const Unit&) const {}
};

__device__ __forceinline__ unsigned cvt_pk_bf16(float lo, float hi) { unsigned r; asm volatile("v_cvt_pk_bf16_f32 %0, %1, %2" : "=v"(r) : "v"(lo), "v"(hi)); return r; }
typedef float f32x2 __attribute__((ext_vector_type(2)));

template <class Epi, class Sched, bool ALIGN_EPI = false, bool SP2 = false>
__device__ __forceinline__ void gemm_phase(PG8_LAS unsigned char* lds, const Gemm g, const Sched& S, const Epi& E, const int tid) {
    const int wid = __builtin_amdgcn_readfirstlane(tid >> 6), lane = tid & 63, wr = wid >> 2, wc = wid & 3, fr = lane & 15, fq = lane >> 4;
    const int K = g.K, nt = K / BK;
    unsigned voffA[2], voffB[2];
#pragma unroll
    for (int i = 0; i < 2; ++i) { int R, C; stage_rc(tid * 16 + i * 8192, R, C); const int Rb = Epi::PERM ? ((R & ~31) + perm32(R & 31)) : R;
        voffA[i] = (unsigned)(R * K + C) * 2u; voffB[i] = (unsigned)(Rb * K + C) * 2u; }
    const size_t kstep = (size_t)(BK * 2);
    const size_t hstep = (size_t)HALF * K * 2;
    const size_t tstep = 2 * hstep;
    const unsigned ldsw = (unsigned)wid * 1024u;
    const int aoff = lds_byte(wr * 64 + fr, fq * 8), boff = lds_byte(wc * 32 + fr, fq * 8);
#define PG8_SA(b, h) (((b) * 2 + (h)) * HTB)
#define PG8_SB(b, h) ((4 + (b) * 2 + (h)) * HTB)
#define PG8_STAGE(bufoff, gbase, voff) do { _Pragma("unroll") for (int _i = 0; _i < 2; ++_i) \
        __builtin_amdgcn_global_load_lds((const unsigned*)((const char*)(gbase) + (voff)[_i]), (PG8_LAS unsigned*)(lds + (bufoff) + ldsw + _i * 8192), 16, 0, 0); } while (0)
#define PG8_LDA(dst, b, h) do { _Pragma("unroll") for (int m = 0; m < 4; ++m) _Pragma("unroll") for (int k = 0; k < 2; ++k) dst[m][k] = *(const PG8_LAS bf16x8*)(lds + PG8_SA(b, h) + aoff + m * 2048 + k * 1024); } while (0)
#define PG8_LDB(dst, b, h) do { _Pragma("unroll") for (int n = 0; n < 2; ++n) _Pragma("unroll") for (int k = 0; k < 2; ++k) dst[n][k] = *(const PG8_LAS bf16x8*)(lds + PG8_SB(b, h) + boff + n * 2048 + k * 1024); } while (0)
#define PG8_MMA(ai, bj, At, Bt) do { __builtin_amdgcn_s_setprio(1); _Pragma("unroll") for (int m = 0; m < 4; ++m) _Pragma("unroll") for (int n = 0; n < 2; ++n) _Pragma("unroll") for (int k = 0; k < 2; ++k) \
        acc[ai][bj][m][n] = __builtin_amdgcn_mfma_f32_16x16x32_bf16(Bt[n][k], At[m][k], acc[ai][bj][m][n], 0, 0, 0); __builtin_amdgcn_s_setprio(0); } while (0)
#define PG8_WAIT_V(n) asm volatile("s_waitcnt vmcnt(" #n ")" ::: "memory")
#define PG8_WAIT_VR(rx) asm volatile("s_cmp_eq_u32 %0, 0\n\ts_cbranch_scc1 2\n\ts_waitcnt vmcnt(%1)\n\ts_branch 1\n\ts_waitcnt vmcnt(8)" :: "s"(rx), "n"(8 + Epi::NST) : "memory", "scc")
#define PG8_WAIT_L(n) asm volatile("s_waitcnt lgkmcnt(" #n ")" ::: "memory")
#define PG8_BAR __builtin_amdgcn_s_barrier()
#define PG8_SCHED __builtin_amdgcn_sched_barrier(0)
    Unit cur, nxt; int ui = 0;
    if (!S.next(0, cur)) return;
    f32x4 acc[2][2][4][2];
#pragma unroll
    for (int a = 0; a < 2; ++a)
#pragma unroll
        for (int b = 0; b < 2; ++b)
#pragma unroll
            for (int m = 0; m < 4; ++m)
#pragma unroll
                for (int n = 0; n < 2; ++n) acc[a][b][m][n] = (f32x4){0.f, 0.f, 0.f, 0.f};
    bf16x8 At[4][2], B0[2][2], B1[2][2];
    const char* cA = (const char*)g.A + (size_t)cur.pm * tstep; const char* cB = (const char*)g.Bt + (size_t)cur.pn * tstep;
    S.a_ready(cur);
    if constexpr (SP2) {
        PG8_STAGE(PG8_SB(0, 0), cB, voffB); PG8_STAGE(PG8_SB(0, 1), cB + hstep, voffB); PG8_STAGE(PG8_SA(0, 0), cA, voffA); PG8_STAGE(PG8_SA(0, 1), cA + hstep, voffA);
        if (wr == 1) PG8_BAR;
        PG8_WAIT_V(2); PG8_BAR;
        PG8_STAGE(PG8_SB(1, 0), cB + kstep, voffB); PG8_STAGE(PG8_SA(1, 0), cA + kstep, voffA); PG8_STAGE(PG8_SB(1, 1), cB + hstep + kstep, voffB);
        PG8_WAIT_V(6); PG8_BAR;
    } else {
        PG8_STAGE(PG8_SB(0, 0), cB, voffB); PG8_STAGE(PG8_SA(0, 0), cA, voffA); PG8_STAGE(PG8_SB(0, 1), cB + hstep, voffB); PG8_STAGE(PG8_SA(0, 1), cA + hstep, voffA);
        if (wr == 1) PG8_BAR;
        PG8_WAIT_V(4); PG8_BAR;
        PG8_STAGE(PG8_SB(1, 0), cB + kstep, voffB); PG8_STAGE(PG8_SA(1, 0), cA + kstep, voffA); PG8_STAGE(PG8_SB(1, 1), cB + hstep + kstep, voffB);
        PG8_WAIT_V(6); PG8_BAR;
    }
    for (;;) {
        const bool has_next = S.next(ui + 1, nxt);
        const char* nA = has_next ? (const char*)g.A + (size_t)nxt.pm * tstep : cA; const char* nB = has_next ? (const char*)g.Bt + (size_t)nxt.pn * tstep : cB;
        for (int t = 0; t < nt; t += 2) {
            const bool last = (t == nt - 2);
            const char* a1 = cA + (size_t)(t + 1) * kstep;
            const char* a2 = last ? nA : cA + (size_t)(t + 2) * kstep; const char* b2 = last ? nB : cB + (size_t)(t + 2) * kstep;
            const char* a3 = a2 + kstep; const char* b3 = b2 + kstep;
            if (last && has_next) S.a_ready(nxt);
            if constexpr (SP2) {
            PG8_LDB(B0, 0, 0); PG8_LDB(B1, 0, 1); PG8_SCHED; PG8_LDA(At, 0, 0); PG8_STAGE(PG8_SA(1, 1), a1 + hstep, voffA);
            PG8_WAIT_V(8); PG8_WAIT_L(0); PG8_BAR; PG8_MMA(0, 0, At, B0); PG8_MMA(0, 1, At, B1); PG8_BAR; PG8_SCHED;
            PG8_LDA(At, 0, 1); PG8_STAGE(PG8_SB(0, 0), b2, voffB); PG8_STAGE(PG8_SB(0, 1), b2 + hstep, voffB); PG8_STAGE(PG8_SA(0, 0), a2, voffA);
            PG8_WAIT_V(8); PG8_WAIT_L(0); PG8_BAR; PG8_MMA(1, 0, At, B0); PG8_MMA(1, 1, At, B1); PG8_BAR; PG8_SCHED;
            PG8_LDB(B0, 1, 0); PG8_LDB(B1, 1, 1); PG8_SCHED; PG8_LDA(At, 1, 0); PG8_STAGE(PG8_SA(0, 1), a2 + hstep, voffA);
            PG8_WAIT_V(8); PG8_WAIT_L(0); PG8_BAR; PG8_MMA(0, 0, At, B0); PG8_MMA(0, 1, At, B1); PG8_BAR; PG8_SCHED;
            PG8_LDA(At, 1, 1); PG8_STAGE(PG8_SB(1, 0), b3, voffB); PG8_STAGE(PG8_SB(1, 1), b3 + hstep, voffB); PG8_STAGE(PG8_SA(1, 0), a3, voffA);
            PG8_WAIT_V(8); PG8_WAIT_L(0); PG8_BAR; PG8_MMA(1, 0, At, B0); PG8_MMA(1, 1, At, B1); PG8_BAR; PG8_SCHED;
            } else {
            PG8_LDB(B0, 0, 0); PG8_SCHED; PG8_LDA(At, 0, 0); PG8_STAGE(PG8_SA(1, 1), a1 + hstep, voffA);
            PG8_WAIT_L(8); PG8_BAR; PG8_WAIT_L(0); PG8_MMA(0, 0, At, B0); PG8_BAR; PG8_SCHED;
            PG8_LDB(B1, 0, 1); PG8_STAGE(PG8_SB(0, 0), b2, voffB);
            PG8_BAR; PG8_WAIT_L(0); PG8_MMA(0, 1, At, B1); PG8_BAR;
            PG8_LDA(At, 0, 1); PG8_STAGE(PG8_SA(0, 0), a2, voffA);
            PG8_BAR; PG8_WAIT_L(0); PG8_MMA(1, 0, At, B0); PG8_BAR; PG8_SCHED;
            PG8_STAGE(PG8_SB(0, 1), b2 + hstep, voffB);
            PG8_WAIT_V(6); PG8_BAR; PG8_MMA(1, 1, At, B1); PG8_BAR;
            PG8_LDB(B0, 1, 0); PG8_SCHED; PG8_LDA(At, 1, 0); PG8_STAGE(PG8_SA(0, 1), a2 + hstep, voffA);
            PG8_WAIT_L(8); PG8_BAR; PG8_WAIT_L(0); PG8_MMA(0, 0, At, B0); PG8_BAR; PG8_SCHED;
            PG8_LDB(B1, 1, 1); PG8_STAGE(PG8_SB(1, 0), b3, voffB);
            PG8_BAR; PG8_WAIT_L(0); PG8_MMA(0, 1, At, B1); PG8_BAR;
            PG8_LDA(At, 1, 1); PG8_STAGE(PG8_SA(1, 0), a3, voffA);
            PG8_BAR; PG8_WAIT_L(0); PG8_MMA(1, 0, At, B0); PG8_BAR; PG8_SCHED;
            PG8_STAGE(PG8_SB(1, 1), b3 + hstep, voffB);
            PG8_WAIT_V(6); PG8_BAR; PG8_MMA(1, 1, At, B1); PG8_BAR;
            }
        }
        if constexpr (ALIGN_EPI) { if (wr == 0) PG8_BAR; }
        if constexpr (!Epi::AFTER_DRAIN) { E(acc, cur, wr, wc, fr, fq); S.done(cur); }
        if (!has_next) break;
#pragma unroll
        for (int a = 0; a < 2; ++a)
#pragma unroll
            for (int b = 0; b < 2; ++b)
#pragma unroll
                for (int m = 0; m < 4; ++m)
#pragma unroll
                    for (int n = 0; n < 2; ++n) acc[a][b][m][n] = (f32x4){0.f, 0.f, 0.f, 0.f};
        cur = nxt; cA = nA; cB = nB; ++ui;
        if constexpr (ALIGN_EPI) { if (wr == 1) PG8_BAR; }
    }
    PG8_WAIT_V(0);
    if constexpr (!ALIGN_EPI) { if (wr == 0) PG8_BAR; }
    PG8_BAR;
    if constexpr (Epi::AFTER_DRAIN) { E.fused(acc, cur, wr, wc, fr, fq, lds, wid, lane); S.done(cur); }
#undef PG8_SA
#undef PG8_SB
#undef PG8_STAGE
#undef PG8_LDA
#undef PG8_LDB
#undef PG8_MMA
#undef PG8_WAIT_V
#undef PG8_WAIT_VR
#undef PG8_WAIT_L
#undef PG8_BAR
#undef PG8_SCHED
}
}

#define LAS __attribute__((address_space(3)))
typedef unsigned short bf16;
typedef short bf16x8 __attribute__((ext_vector_type(8)));
typedef short s16x4 __attribute__((ext_vector_type(4)));
typedef float f32x4 __attribute__((ext_vector_type(4)));
typedef float f32x2 __attribute__((ext_vector_type(2)));
typedef float f32x16 __attribute__((ext_vector_type(16)));
typedef unsigned u32x4 __attribute__((ext_vector_type(4)));
typedef unsigned u32x2 __attribute__((ext_vector_type(2)));
typedef __bf16 bf16x2_t __attribute__((ext_vector_type(2)));

constexpr int NTOK = 32768, DM = 1024, DFF = 2816, DIN = 1792, SEQ = 4096, NBATCH = 8, MEML = 256, NMEM = NBATCH * MEML;
constexpr float EPS = 1e-6f;
constexpr float LOG2E = 1.4426950408889634f;
constexpr size_t MiB = (size_t)1 << 20;
constexpr size_t WS_SS = 0, WS_MK = 2 * MiB, WS_VT = 4 * MiB, WS_WMK = 6 * MiB, WS_WMV = 7 * MiB, WS_MEMN = 8 * MiB, WS_MEMNP = 12 * MiB;
constexpr size_t WS_W0 = 16 * MiB, WS_WL = 40 * MiB;
constexpr size_t OFF_WUP1 = 0, OFF_WDN1 = OFF_WUP1 + (size_t)5632 * 1024 * 2, OFF_WIN = OFF_WDN1 + (size_t)1024 * 2816 * 2, OFF_WOUT = OFF_WIN + (size_t)1792 * 1024 * 2,
                 OFF_WUP2 = OFF_WOUT + (size_t)1024 * 1024 * 2, OFF_WDN2 = OFF_WUP2 + (size_t)5632 * 1024 * 2, OFF_WEND = OFF_WDN2 + (size_t)1024 * 2816 * 2;
static_assert(OFF_WEND <= WS_WL, "weight block");
constexpr size_t WS_HB = 96 * MiB, WS_ACT = 160 * MiB, WS_P = WS_ACT, WS_MIXED = WS_ACT + 112 * MiB, WS_END = WS_ACT + 176 * MiB;
constexpr size_t WS_CTL = WS_END, CTL_BYTES = 16384, WS_TOTAL = WS_END + CTL_BYTES;
constexpr int LDS_BYTES = 147456, LDS_BARW = LDS_BYTES - 64;
constexpr int NPHASE = 16;

__device__ __forceinline__ unsigned cvtpk(float lo, float hi) { f32x2 v = {lo, hi}; bf16x2_t b = __builtin_convertvector(v, bf16x2_t); return __builtin_bit_cast(unsigned, b); }
__device__ __forceinline__ void unpack8(const u32x4 w, float (&f)[8]) {
    f[0] = __uint_as_float(w.x << 16); f[1] = __uint_as_float(w.x & 0xffff0000u); f[2] = __uint_as_float(w.y << 16); f[3] = __uint_as_float(w.y & 0xffff0000u);
    f[4] = __uint_as_float(w.z << 16); f[5] = __uint_as_float(w.z & 0xffff0000u); f[6] = __uint_as_float(w.w << 16); f[7] = __uint_as_float(w.w & 0xffff0000u);
}
__device__ __forceinline__ float xsum32(float v) { const auto rr = __builtin_amdgcn_permlane32_swap(__float_as_uint(v), __float_as_uint(v), false, false); return __uint_as_float(rr[0]) + __uint_as_float(rr[1]); }
__device__ __forceinline__ float xmax32(float v) { const auto rr = __builtin_amdgcn_permlane32_swap(__float_as_uint(v), __float_as_uint(v), false, false); return fmaxf(__uint_as_float(rr[0]), __uint_as_float(rr[1])); }
__device__ __forceinline__ float xsum16(float v) { const auto rr = __builtin_amdgcn_permlane16_swap(__float_as_uint(v), __float_as_uint(v), false, false); return __uint_as_float(rr[0]) + __uint_as_float(rr[1]); }
__device__ __forceinline__ float wave_sum(float v) {
#pragma unroll
    for (int o = 1; o < 64; o <<= 1) v += __shfl_xor(v, o);
    return v;
}
__device__ __forceinline__ float row_rstd(const float* ss, int row) {
    const f32x4* p = (const f32x4*)(ss + (size_t)row * 16);
    const f32x4 a = p[0], b = p[1], c = p[2], d = p[3];
    const float s = (((a.x + a.y) + (a.z + a.w)) + ((b.x + b.y) + (b.z + b.w))) + (((c.x + c.y) + (c.z + c.w)) + ((d.x + d.y) + (d.z + d.w)));
    return __builtin_amdgcn_rsqf(s * (1.0f / 1024.0f) + EPS);
}
__device__ __forceinline__ void rows_rstd(const float* ss, int row0, int fq, float (&r)[8]) {
    f32x4 p[8];
#pragma unroll
    for (int i = 0; i < 8; ++i) p[i] = *(const f32x4*)(ss + (size_t)(row0 + (i >> 2) * 128 + (i & 3) * 16) * 16 + 4 * fq);
#pragma unroll
    for (int i = 0; i < 8; ++i) { float t = (p[i].x + p[i].y) + (p[i].z + p[i].w); t = xsum16(t); t = xsum32(t); r[i] = __builtin_amdgcn_rsqf(t * (1.0f / 1024.0f) + EPS); }
}
__device__ __forceinline__ float silu_f(float x) { return x * __builtin_amdgcn_rcpf(1.0f + __builtin_amdgcn_exp2f(-x * LOG2E)); }

struct EpiSwiglu {
    static constexpr bool PERM = true, AFTER_DRAIN = false;
    bf16* O; const float* ss; int skip;
    __device__ __forceinline__ void operator()(const pg8::f32x4 (&acc)[2][2][4][2], const pg8::Unit& u, int wr, int wc, int fr, int fq) const {
        if (skip == 1) return;
        const int row0 = u.pm * 256 + wr * 64 + fr, col0 = u.pn * 128 + wc * 32 + 8 * fq;
        float rr[8];
        if (skip == 2) {
#pragma unroll
            for (int i = 0; i < 8; ++i) rr[i] = 1.0f; } else rows_rstd(ss, row0, fq, rr);
#pragma unroll
        for (int ai = 0; ai < 2; ++ai)
#pragma unroll
            for (int m = 0; m < 4; ++m) {
                const int row = row0 + ai * 128 + m * 16; const float r = rr[ai * 4 + m];
                const f32x4 g0 = acc[ai][0][m][0] * r, g1 = acc[ai][0][m][1] * r, u0 = acc[ai][1][m][0] * r, u1 = acc[ai][1][m][1] * r;
                u32x4 w;
                if (skip == 2) { w.x = cvtpk(g0[0] * u0[0], g0[1] * u0[1]); w.y = cvtpk(g0[2] * u0[2], g0[3] * u0[3]); w.z = cvtpk(g1[0] * u1[0], g1[1] * u1[1]); w.w = cvtpk(g1[2] * u1[2], g1[3] * u1[3]); }
                else {
                w.x = cvtpk(silu_f(g0[0]) * u0[0], silu_f(g0[1]) * u0[1]); w.y = cvtpk(silu_f(g0[2]) * u0[2], silu_f(g0[3]) * u0[3]);
                w.z = cvtpk(silu_f(g1[0]) * u1[0], silu_f(g1[1]) * u1[1]); w.w = cvtpk(silu_f(g1[2]) * u1[2], silu_f(g1[3]) * u1[3]); }
                if (skip != 3 || (w.x == 0x7fc1a5a5u && w.y == 0x12345678u)) *(u32x4*)(O + (size_t)row * DFF + col0) = w;
            }
    }
};
struct EpiResid {
    static constexpr bool PERM = true, AFTER_DRAIN = false;
    bf16* hb; float* ss; float scale;
    __device__ __forceinline__ void operator()(const pg8::f32x4 (&acc)[2][2][4][2], const pg8::Unit& u, int wr, int wc, int fr, int fq) const {
        const int row0 = u.pm * 256 + wr * 64 + fr, col0 = u.pn * 256 + wc * 32 + 8 * fq;
        u32x4 bv[4][2];
#pragma unroll
        for (int m = 0; m < 4; ++m)
#pragma unroll
            for (int bj = 0; bj < 2; ++bj) bv[m][bj] = *(const u32x4*)(hb + (size_t)(row0 + m * 16) * DM + col0 + bj * 128);
        asm volatile("" ::: "memory");
#pragma unroll
        for (int ai = 0; ai < 2; ++ai)
#pragma unroll
            for (int m = 0; m < 4; ++m) {
                const int row = row0 + ai * 128 + m * 16; float sq = 0.f;
#pragma unroll
                for (int bj = 0; bj < 2; ++bj) {
                    const size_t off = (size_t)row * DM + col0 + bj * 128;
                    float b[8]; unpack8(bv[m][bj], b);
                    if (ai == 0) bv[m][bj] = *(const u32x4*)(hb + off + (size_t)128 * DM);
                    const f32x4 a0 = acc[ai][bj][m][0] * scale, a1 = acc[ai][bj][m][1] * scale;
                    const float v0 = b[0] + a0[0], v1 = b[1] + a0[1], v2 = b[2] + a0[2], v3 = b[3] + a0[3], v4 = b[4] + a1[0], v5 = b[5] + a1[1], v6 = b[6] + a1[2], v7 = b[7] + a1[3];
                    u32x4 w; w.x = cvtpk(v0, v1); w.y = cvtpk(v2, v3); w.z = cvtpk(v4, v5); w.w = cvtpk(v6, v7);
                    *(u32x4*)(hb + off) = w;
                    sq += ((v0 * v0 + v1 * v1) + (v2 * v2 + v3 * v3)) + ((v4 * v4 + v5 * v5) + (v6 * v6 + v7 * v7));
                }
                sq = xsum16(sq); sq = xsum32(sq);
                if (fq == 0) ss[(size_t)row * 16 + u.pn * 4 + wc] = sq;
            }
    }
};
struct EpiScaleBf16 {
    static constexpr bool PERM = true, AFTER_DRAIN = false;
    bf16* O; int ldc; const float* ss;
    __device__ __forceinline__ void operator()(const pg8::f32x4 (&acc)[2][2][4][2], const pg8::Unit& u, int wr, int wc, int fr, int fq) const {
        const int row0 = u.pm * 256 + wr * 64 + fr, col0 = u.pn * 256 + wc * 32 + 8 * fq;
        float rr[8];
        if (ss) rows_rstd(ss, row0, fq, rr); else {
#pragma unroll
            for (int i = 0; i < 8; ++i) rr[i] = 1.0f; }
#pragma unroll
        for (int ai = 0; ai < 2; ++ai)
#pragma unroll
            for (int m = 0; m < 4; ++m) {
                const int row = row0 + ai * 128 + m * 16; const float r = rr[ai * 4 + m];
#pragma unroll
                for (int bj = 0; bj < 2; ++bj) {
                    const f32x4 v0 = acc[ai][bj][m][0] * r, v1 = acc[ai][bj][m][1] * r;
                    u32x4 w; w.x = cvtpk(v0[0], v0[1]); w.y = cvtpk(v0[2], v0[3]); w.z = cvtpk(v1[0], v1[1]); w.w = cvtpk(v1[2], v1[3]);
                    *(u32x4*)(O + (size_t)row * ldc + col0 + bj * 128) = w;
                }
            }
    }
};

__device__ __forceinline__ void tr_item(const float* __restrict__ W, int ldw, int K, const float* __restrict__ g, bf16* __restrict__ WT, int item, int nblk, int mode, int row_off, LAS float* scr, int lane) {
    const int kb = item / nblk, nb = item - kb * nblk, k0 = 64 * kb, n0 = 32 * nb;
    int drow;
    if (mode) { const int bj = n0 / DFF, rem = n0 - bj * DFF; drow = 256 * (rem >> 7) + 128 * bj + (rem & 127); } else drow = row_off + n0;
    {
        const int kq = lane >> 3, n4 = (lane & 7) * 4; f32x4 v[8]; float gv[8];
#pragma unroll
        for (int i = 0; i < 8; ++i) { v[i] = *(const f32x4*)(W + (size_t)(k0 + kq + 8 * i) * ldw + n0 + n4); gv[i] = g ? g[k0 + kq + 8 * i] : 1.0f; }
#pragma unroll
        for (int i = 0; i < 8; ++i) { LAS float* d = scr + (kq + 8 * i) * 33 + n4; d[0] = v[i].x * gv[i]; d[1] = v[i].y * gv[i]; d[2] = v[i].z * gv[i]; d[3] = v[i].w * gv[i]; }
    }
    asm volatile("s_waitcnt lgkmcnt(0)" ::: "memory");
    const int c = lane & 7;
#pragma unroll
    for (int j = 0; j < 4; ++j) { const int n = (lane >> 3) + 8 * j; const LAS float* s = scr + (8 * c) * 33 + n;
        u32x4 o; o.x = cvtpk(s[0 * 33], s[1 * 33]); o.y = cvtpk(s[2 * 33], s[3 * 33]); o.z = cvtpk(s[4 * 33], s[5 * 33]); o.w = cvtpk(s[6 * 33], s[7 * 33]);
        *(u32x4*)(WT + (size_t)(drow + n) * K + k0 + 8 * c) = o; }
    asm volatile("s_waitcnt lgkmcnt(0)" ::: "memory");
}

struct Args { const float *x, *mem, *g_ffn1, *w_ffn1_up, *w_ffn1_down, *g_mix, *w_in, *conv_w, *sinks, *g_mem, *w_mem_kv, *g_grp, *w_out, *g_ffn2, *w_ffn2_up, *w_ffn2_down, *g_final;
              float* out; unsigned char* ws; int ph_lo, ph_hi, coop, dup; };

__device__ __forceinline__ void prologue(const Args& a, LAS unsigned char* lds, int gw, int NGW, int wave, int lane) {
    LAS float* scr = (LAS float*)(lds + wave * 16384);
    unsigned char* ws = a.ws;
    constexpr int I_UP = 16 * 176, I_DN = 44 * 32, I_IN = 16 * 56, I_OUT = 16 * 32, I_MEM = 16 * 8;
    constexpr int I_LAYER = 2 * I_UP + 2 * I_DN + I_IN + I_OUT + 2 * I_MEM;
    for (int it = gw; it < 2 * I_LAYER; it += NGW) {
        const int l = it >= I_LAYER ? 1 : 0; int r = it - l * I_LAYER;
        unsigned char* wl = ws + WS_W0 + (size_t)l * WS_WL;
        if (r < I_UP) { tr_item(a.w_ffn1_up + (size_t)l * DM * 2 * DFF, 2 * DFF, DM, a.g_ffn1 + l * DM, (bf16*)(wl + OFF_WUP1), r, 176, 1, 0, scr, lane); continue; } r -= I_UP;
        if (r < I_UP) { tr_item(a.w_ffn2_up + (size_t)l * DM * 2 * DFF, 2 * DFF, DM, a.g_ffn2 + l * DM, (bf16*)(wl + OFF_WUP2), r, 176, 1, 0, scr, lane); continue; } r -= I_UP;
        if (r < I_DN) { tr_item(a.w_ffn1_down + (size_t)l * DFF * DM, DM, DFF, nullptr, (bf16*)(wl + OFF_WDN1), r, 32, 0, 0, scr, lane); continue; } r -= I_DN;
        if (r < I_DN) { tr_item(a.w_ffn2_down + (size_t)l * DFF * DM, DM, DFF, nullptr, (bf16*)(wl + OFF_WDN2), r, 32, 0, 0, scr, lane); continue; } r -= I_DN;
        if (r < I_IN) { tr_item(a.w_in + (size_t)l * DM * DIN, DIN, DM, a.g_mix + l * DM, (bf16*)(wl + OFF_WIN), r, 56, 0, 0, scr, lane); continue; } r -= I_IN;
        if (r < I_OUT) { tr_item(a.w_out + (size_t)l * DM * DM, DM, DM, a.g_grp + l * DM, (bf16*)(wl + OFF_WOUT), r, 32, 0, 0, scr, lane); continue; } r -= I_OUT;
        if (r < I_MEM) { tr_item(a.w_mem_kv + (size_t)l * DM * 512, 512, DM, a.g_mem + l * DM, (bf16*)(ws + WS_WMK), r, 8, 0, l * 256, scr, lane); continue; } r -= I_MEM;
        tr_item(a.w_mem_kv + (size_t)l * DM * 512 + 256, 512, DM, a.g_mem + l * DM, (bf16*)(ws + WS_WMV), r, 8, 0, l * 256, scr, lane);
    }
    bf16* hb = (bf16*)(ws + WS_HB); float* ss = (float*)(ws + WS_SS);
    for (int m0 = gw; m0 < NTOK; m0 += 2 * NGW) {
        f32x4 v[2][4]; float s[2] = {0.f, 0.f};
#pragma unroll
        for (int q = 0; q < 2; ++q) { const int mr = (m0 + q * NGW < NTOK) ? m0 + q * NGW : m0; const f32x4* xr = (const f32x4*)(a.x + (size_t)mr * DM) + lane;
#pragma unroll
            for (int j = 0; j < 4; ++j) v[q][j] = xr[64 * j]; }
#pragma unroll
        for (int q = 0; q < 2; ++q) { const int m = m0 + q * NGW; if (m >= NTOK) break;
#pragma unroll
            for (int j = 0; j < 4; ++j) s[q] += (v[q][j].x * v[q][j].x + v[q][j].y * v[q][j].y) + (v[q][j].z * v[q][j].z + v[q][j].w * v[q][j].w);
            const float tot = wave_sum(s[q]);
            u32x2* o8 = (u32x2*)(hb + (size_t)m * DM) + lane;
#pragma unroll
            for (int j = 0; j < 4; ++j) { u32x2 o; o.x = cvtpk(v[q][j].x, v[q][j].y); o.y = cvtpk(v[q][j].z, v[q][j].w); o8[64 * j] = o; }
            if (lane < 16) ss[(size_t)m * 16 + lane] = lane == 0 ? tot : 0.f; }
    }
    bf16* memn = (bf16*)(ws + WS_MEMN); bf16* memnp = (bf16*)(ws + WS_MEMNP);
    for (int m = gw; m < NMEM; m += NGW) {
        const f32x4* xr = (const f32x4*)(a.mem + (size_t)m * DM) + lane; f32x4 v[4]; float s = 0.f;
#pragma unroll
        for (int j = 0; j < 4; ++j) { v[j] = xr[64 * j]; s += (v[j].x * v[j].x + v[j].y * v[j].y) + (v[j].z * v[j].z + v[j].w * v[j].w); }
        const float rstd = __builtin_amdgcn_rsqf(wave_sum(s) * (1.0f / DM) + EPS);
        const int kk = m & 15, mp = (m & ~15) + 8 * ((kk >> 2) & 1) + 4 * ((kk >> 3) & 1) + (kk & 3);
        u32x2* o8 = (u32x2*)(memn + (size_t)m * DM) + lane; u32x2* p8 = (u32x2*)(memnp + (size_t)mp * DM) + lane;
#pragma unroll
        for (int j = 0; j < 4; ++j) { u32x2 o; o.x = cvtpk(v[j].x * rstd, v[j].y * rstd); o.y = cvtpk(v[j].z * rstd, v[j].w * rstd); o8[64 * j] = o; p8[64 * j] = o; }
    }
}

__device__ __forceinline__ void final_norm(const Args& a, int gw, int NGW, int lane) {
    const float* ss = (const float*)(a.ws + WS_SS); const bf16* hb = (const bf16*)(a.ws + WS_HB);
    f32x4 gv[4];
#pragma unroll
    for (int j = 0; j < 4; ++j) gv[j] = ((const f32x4*)a.g_final)[64 * j + lane];
    for (int m0 = gw; m0 < NTOK; m0 += 2 * NGW) {
        f32x4 p[2][4]; u32x2 hv[2][4];
#pragma unroll
        for (int q = 0; q < 2; ++q) { const int m = (m0 + q * NGW < NTOK) ? m0 + q * NGW : m0; const f32x4* sp = (const f32x4*)(ss + (size_t)m * 16); const u32x2* hr = (const u32x2*)(hb + (size_t)m * DM) + lane;
#pragma unroll
            for (int j = 0; j < 4; ++j) { p[q][j] = sp[j]; hv[q][j] = hr[64 * j]; } }
#pragma unroll
        for (int q = 0; q < 2; ++q) { const int m = m0 + q * NGW; if (m >= NTOK) break;
            const float sm = (((p[q][0].x + p[q][0].y) + (p[q][0].z + p[q][0].w)) + ((p[q][1].x + p[q][1].y) + (p[q][1].z + p[q][1].w))) + (((p[q][2].x + p[q][2].y) + (p[q][2].z + p[q][2].w)) + ((p[q][3].x + p[q][3].y) + (p[q][3].z + p[q][3].w)));
            const float r = __builtin_amdgcn_rsqf(sm * (1.0f / 1024.0f) + EPS);
            f32x4* xr = (f32x4*)(a.out + (size_t)m * DM) + lane;
#pragma unroll
            for (int j = 0; j < 4; ++j) { f32x4 v;
                v.x = __uint_as_float(hv[q][j].x << 16); v.y = __uint_as_float(hv[q][j].x & 0xffff0000u); v.z = __uint_as_float(hv[q][j].y << 16); v.w = __uint_as_float(hv[q][j].y & 0xffff0000u);
                xr[64 * j] = v * r * gv[j]; } }
    }
}

__device__ __forceinline__ int crow(int i, int h) { return (i & 3) + 8 * (i >> 2) + 4 * h; }
__device__ __forceinline__ bf16x8 pack8(const f32x16& s, int o) {
    u32x4 w; w.x = cvtpk(s[o + 0], s[o + 1]); w.y = cvtpk(s[o + 2], s[o + 3]); w.z = cvtpk(s[o + 4], s[o + 5]); w.w = cvtpk(s[o + 6], s[o + 7]);
    return __builtin_bit_cast(bf16x8, w);
}
__device__ __forceinline__ f32x16 zero16() { f32x16 z;
#pragma unroll
    for (int i = 0; i < 16; ++i) z[i] = 0.f;
    return z; }
typedef short v4i16_t __attribute__((ext_vector_type(4)));
__device__ __forceinline__ s16x4 vtr(LAS unsigned char* p) { return __builtin_bit_cast(s16x4, __builtin_amdgcn_ds_read_tr16_b64_v4i16((LAS v4i16_t*)p)); }
__device__ __forceinline__ void store_ot(bf16* dst, const f32x16& o0, const f32x16& o1, float rs, int h) {
#pragma unroll
    for (int g = 0; g < 4; ++g) {
        u32x2 w0; w0.x = cvtpk(o0[4 * g] * rs, o0[4 * g + 1] * rs); w0.y = cvtpk(o0[4 * g + 2] * rs, o0[4 * g + 3] * rs);
        u32x2 w1; w1.x = cvtpk(o1[4 * g] * rs, o1[4 * g + 1] * rs); w1.y = cvtpk(o1[4 * g + 2] * rs, o1[4 * g + 3] * rs);
        *(u32x2*)(dst + 8 * g + 4 * h) = w0; *(u32x2*)(dst + 32 + 8 * g + 4 * h) = w1;
    }
}
__device__ __forceinline__ void pack_ot(u32x4 (&pk)[4], const f32x16& o0, const f32x16& o1) {
#pragma unroll
    for (int g2 = 0; g2 < 2; ++g2) {
        pk[g2].x = cvtpk(o0[8 * g2], o0[8 * g2 + 1]); pk[g2].y = cvtpk(o0[8 * g2 + 2], o0[8 * g2 + 3]); pk[g2].z = cvtpk(o0[8 * g2 + 4], o0[8 * g2 + 5]); pk[g2].w = cvtpk(o0[8 * g2 + 6], o0[8 * g2 + 7]);
        pk[2 + g2].x = cvtpk(o1[8 * g2], o1[8 * g2 + 1]); pk[2 + g2].y = cvtpk(o1[8 * g2 + 2], o1[8 * g2 + 3]); pk[2 + g2].z = cvtpk(o1[8 * g2 + 4], o1[8 * g2 + 5]); pk[2 + g2].w = cvtpk(o1[8 * g2 + 6], o1[8 * g2 + 7]); }
}
__device__ __forceinline__ void store_pk(bf16* dst, const u32x4 (&pk)[4], float rs, int h) {
#pragma unroll
    for (int i = 0; i < 4; ++i) { float f[8]; unpack8(pk[i], f); const int dt = i >> 1, g0 = 2 * (i & 1);
        u32x2 w0; w0.x = cvtpk(f[0] * rs, f[1] * rs); w0.y = cvtpk(f[2] * rs, f[3] * rs);
        u32x2 w1; w1.x = cvtpk(f[4] * rs, f[5] * rs); w1.y = cvtpk(f[6] * rs, f[7] * rs);
        *(u32x2*)(dst + 32 * dt + 8 * g0 + 4 * h) = w0; *(u32x2*)(dst + 32 * dt + 8 * (g0 + 1) + 4 * h) = w1; }
}
__device__ __forceinline__ void store_pk_lds(LAS unsigned char* wbuf, bf16* gbase, const u32x4 (&pk)[4], float rs, int r, int h, int lane) {
#pragma unroll
    for (int i = 0; i < 4; ++i) { float f[8]; unpack8(pk[i], f); const int c0 = 4 * (i >> 1) + 2 * (i & 1);
        u32x2 w0; w0.x = cvtpk(f[0] * rs, f[1] * rs); w0.y = cvtpk(f[2] * rs, f[3] * rs);
        u32x2 w1; w1.x = cvtpk(f[4] * rs, f[5] * rs); w1.y = cvtpk(f[6] * rs, f[7] * rs);
        *(LAS u32x2*)(wbuf + r * 128 + ((c0 ^ (r & 7)) << 4) + 8 * h) = w0; *(LAS u32x2*)(wbuf + r * 128 + (((c0 + 1) ^ (r & 7)) << 4) + 8 * h) = w1; }
#pragma unroll
    for (int k = 0; k < 4; ++k) { const int row = (lane >> 3) + 8 * k, pc = lane & 7, lc = pc ^ (row & 7);
        const u32x4 v = *(const LAS u32x4*)(wbuf + row * 128 + pc * 16);
        *(u32x4*)(gbase + (size_t)row * DM + 8 * lc) = v; }
}
__device__ __forceinline__ float sumsq16(const f32x16& o) { float s = 0.f;
#pragma unroll
    for (int i = 0; i < 16; ++i) s += o[i] * o[i];
    return s; }

__device__ __forceinline__ void mixer_phase(LAS unsigned char* lds, const bf16* __restrict__ P, const bf16* __restrict__ MK, const bf16* __restrict__ VT, const float* __restrict__ convw,
                                            const float* __restrict__ sinks, bf16* __restrict__ mixed, int layer, int G, int bid, const int tid_arg, const int var) {
    const int tid_in = tid_arg;
    LAS float* ssqS = (LAS float*)(lds + 98304);
    LAS float* ssqM = (LAS float*)(lds + 98304 + 2048);
    LAS float* rsT = (LAS float*)(lds + 98304 + 3072);
    for (int u = bid; u < 512; u += G) {
        int tid = tid_in; asm volatile("" : "+v"(tid));
        const int lane = tid & 63, w = __builtin_amdgcn_readfirstlane(tid >> 6), r = lane & 31, h = lane >> 5;
        const int b = u >> 6, q0 = (u & 63) * 64; const size_t tok0 = (size_t)b * SEQ + q0;
        if (!(var & 8)) {
#pragma unroll
            for (int ps = 0; ps < 12; ++ps) {
                const int blk = ps * 8 + w, isV = blk >= 48 ? 1 : 0, kb = blk - 48 * isV, kvh = kb >= 24 ? 1 : 0, key = 8 * (kb - 24 * kvh) + (lane >> 3), s16 = lane & 7;
                const int c8 = isV ? ((((s16 >> 2) ^ ((key >> 1) & 1)) << 2) | (s16 & 3)) : (s16 ^ ((key >> 1) & 7));
                int pos = q0 - 128 + key; pos = pos < 0 ? 0 : pos;
                const bf16* src = P + ((size_t)b * SEQ + pos) * DIN + 1280 + isV * 128 + kvh * 64 + c8 * 8;
                __builtin_amdgcn_global_load_lds((const unsigned*)src, (LAS unsigned*)(lds + blk * 1024), 16, 0, 0);
            }
        }
        if (!(var & 1)) {
            const int c8 = tid & 31, tg = tid >> 5, c0 = c8 * 8, t0 = 4 * tg;
            float w0[8], w1[8], w2[8];
            { const f32x4 a0 = *(const f32x4*)(convw + c0), a1 = *(const f32x4*)(convw + c0 + 4), b0 = *(const f32x4*)(convw + 256 + c0), b1 = *(const f32x4*)(convw + 256 + c0 + 4),
                          d0 = *(const f32x4*)(convw + 512 + c0), d1 = *(const f32x4*)(convw + 512 + c0 + 4);
#pragma unroll
              for (int j = 0; j < 4; ++j) { w0[j] = a0[j]; w0[4 + j] = a1[j]; w1[j] = b0[j]; w1[4 + j] = b1[j]; w2[j] = d0[j]; w2[4 + j] = d1[j]; } }
            const bool halo = (q0 + t0 - 2 >= 0); const size_t th = halo ? (tok0 + t0 - 2) : tok0;
            u32x4 rh[2][2], rt[4][3];
#pragma unroll
            for (int i = 0; i < 2; ++i) { const bf16* pp = P + (th + i) * DIN + c0; rh[i][0] = *(const u32x4*)(pp + 256); rh[i][1] = *(const u32x4*)(pp + 512); }
#pragma unroll
            for (int i = 0; i < 4; ++i) { const bf16* pp = P + (tok0 + t0 + i) * DIN + c0; rt[i][0] = *(const u32x4*)(pp); rt[i][1] = *(const u32x4*)(pp + 256); rt[i][2] = *(const u32x4*)(pp + 512); }
            float vm2[8], vm1[8];
            { float cg_[8], uu[8]; const float hz = halo ? 1.0f : 0.0f;
              unpack8(rh[0][0], cg_); unpack8(rh[0][1], uu);
#pragma unroll
              for (int j = 0; j < 8; ++j) vm2[j] = cg_[j] * uu[j] * hz;
              unpack8(rh[1][0], cg_); unpack8(rh[1][1], uu);
#pragma unroll
              for (int j = 0; j < 8; ++j) vm1[j] = cg_[j] * uu[j] * hz; }
#pragma unroll
            for (int i = 0; i < 4; ++i) {
                float bg[8], cg_[8], uu[8], y[8];
                unpack8(rt[i][0], bg); unpack8(rt[i][1], cg_); unpack8(rt[i][2], uu);
                float sq = 0.f;
#pragma unroll
                for (int j = 0; j < 8; ++j) { const float v = cg_[j] * uu[j]; y[j] = bg[j] * (w0[j] * vm2[j] + w1[j] * vm1[j] + w2[j] * v); vm2[j] = vm1[j]; vm1[j] = v; sq += y[j] * y[j]; }
#pragma unroll
                for (int o = 1; o < 32; o <<= 1) sq += __shfl_xor(sq, o);
                const float rs = __builtin_amdgcn_rsqf(sq * (1.0f / 256.0f) + EPS);
                u32x4 wv; wv.x = cvtpk(y[0] * rs, y[1] * rs); wv.y = cvtpk(y[2] * rs, y[3] * rs); wv.z = cvtpk(y[4] * rs, y[5] * rs); wv.w = cvtpk(y[6] * rs, y[7] * rs);
                *(u32x4*)(mixed + (tok0 + t0 + i) * DM + c0) = wv;
            }
        }
        asm volatile("s_waitcnt vmcnt(0)" ::: "memory");
        __syncthreads();
        u32x4 HM[4] = {};
        u32x4 HS[2][4] = {};
#pragma unroll 1
        for (int step = 0; step < 2; ++step) {
        if ((step == 0) == (w < 4)) {
        if (!(var & 2)) {
            const int hm = w >> 1, qt = w & 1;
            const bf16* qp = P + (tok0 + 32 * qt + r) * DIN + 1536 + hm * 64 + 8 * h;
            bf16x8 qf[4];
#pragma unroll
            for (int ks = 0; ks < 4; ++ks) qf[ks] = *(const bf16x8*)(qp + 16 * ks);
            const bf16* kp = MK + (size_t)(b * MEML + r) * 512 + layer * 256 + hm * 64 + 8 * h;
            const bf16* vp = VT + (size_t)(layer * 256 + hm * 64 + r) * NMEM + b * MEML + 8 * h;
            const float c = 0.125f * LOG2E;
            f32x16 o0 = zero16(), o1 = zero16(); float mrun = -INFINITY, lrun = 0.f;
#pragma unroll 1
            for (int hf = 0; hf < 2; ++hf) {
                f32x16 S[4];
#pragma unroll
                for (int jp = 0; jp < 2; ++jp) {
                    bf16x8 kf[2][4];
#pragma unroll
                    for (int j2 = 0; j2 < 2; ++j2)
#pragma unroll
                        for (int ks = 0; ks < 4; ++ks) kf[j2][ks] = *(const bf16x8*)(kp + (size_t)(4 * hf + 2 * jp + j2) * 32 * 512 + 16 * ks);
                    __builtin_amdgcn_sched_barrier(0);
#pragma unroll
                    for (int j2 = 0; j2 < 2; ++j2) { S[2 * jp + j2] = zero16();
#pragma unroll
                        for (int ks = 0; ks < 4; ++ks) S[2 * jp + j2] = __builtin_amdgcn_mfma_f32_32x32x16_bf16(kf[j2][ks], qf[ks], S[2 * jp + j2], 0, 0, 0); }
                    __builtin_amdgcn_sched_barrier(0);
                }
                float mx = mrun;
#pragma unroll
                for (int jt = 0; jt < 4; ++jt)
#pragma unroll
                    for (int i = 0; i < 16; ++i) mx = fmaxf(mx, S[jt][i] * c);
                mx = xmax32(mx);
                const float alpha = __builtin_amdgcn_exp2f(mrun - mx);
                float sum = 0.f;
#pragma unroll
                for (int jt = 0; jt < 4; ++jt)
#pragma unroll
                    for (int i = 0; i < 16; ++i) { const float p = __builtin_amdgcn_exp2f(S[jt][i] * c - mx); S[jt][i] = p; sum += p; }
                sum = xsum32(sum);
                lrun = lrun * alpha + sum; mrun = mx;
                o0 = o0 * alpha; o1 = o1 * alpha;
#pragma unroll
                for (int jp = 0; jp < 2; ++jp) {
                    bf16x8 vf[2][2][2];
#pragma unroll
                    for (int j2 = 0; j2 < 2; ++j2)
#pragma unroll
                        for (int s = 0; s < 2; ++s) { const int ko = 32 * (4 * hf + 2 * jp + j2) + 16 * s; vf[j2][s][0] = *(const bf16x8*)(vp + ko); vf[j2][s][1] = *(const bf16x8*)(vp + (size_t)32 * NMEM + ko); }
                    __builtin_amdgcn_sched_barrier(0);
#pragma unroll
                    for (int j2 = 0; j2 < 2; ++j2)
#pragma unroll
                        for (int s = 0; s < 2; ++s) { const bf16x8 pb = pack8(S[2 * jp + j2], 8 * s);
                            o0 = __builtin_amdgcn_mfma_f32_32x32x16_bf16(vf[j2][s][0], pb, o0, 0, 0, 0); o1 = __builtin_amdgcn_mfma_f32_32x32x16_bf16(vf[j2][s][1], pb, o1, 0, 0, 0); }
                    __builtin_amdgcn_sched_barrier(0);
                }
            }
            const float inv = __builtin_amdgcn_rcpf(lrun);
            o0 = o0 * inv; o1 = o1 * inv;
            float sq = sumsq16(o0) + sumsq16(o1); sq = xsum32(sq);
            if (h == 0) ssqM[hm * 64 + 32 * qt + r] = sq;
            pack_ot(HM, o0, o1);
            __builtin_amdgcn_sched_barrier(0);
        }
        } else {
        if (!(var & 4)) {
            const int kvh = w >> 2;
            const float slope2 = __builtin_amdgcn_exp2f(-(float)(w + 1)) * LOG2E, sink2 = sinks[w] * LOG2E, c = 0.125f * LOG2E;
            const int sjmin = 128 - q0;
            LAS unsigned char* Kb = lds + kvh * 24576;
            const int qq = (lane & 15) >> 2, xh = (qq >> 1) & 1;
            LAS unsigned char* Vb = lds + 49152 + kvh * 24576 + (4 * h + qq) * 128 + ((2 * ((lane >> 4) & 1) + ((lane & 3) >> 1)) << 4) + 8 * (lane & 1);
            LAS unsigned char* Vb0 = Vb + (xh << 6); LAS unsigned char* Vb1 = Vb + ((xh ^ 1) << 6);
#pragma unroll
            for (int qt = 0; qt < 2; ++qt) {
                const bf16* qp = P + (tok0 + 32 * qt + r) * DIN + 768 + w * 64 + 8 * h;
                bf16x8 qf[4];
#pragma unroll
                for (int ks = 0; ks < 4; ++ks) qf[ks] = *(const bf16x8*)(qp + 16 * ks);
                f32x16 S[5];
#pragma unroll
                for (int tp = 0; tp < 3; ++tp) {
                    bf16x8 kf[2][4];
#pragma unroll
                    for (int j2 = 0; j2 < 2; ++j2) { const int t5 = 2 * tp + j2; if (t5 < 5) { const int key = 32 * (qt + t5) + r;
#pragma unroll
                        for (int ks = 0; ks < 4; ++ks) kf[j2][ks] = *(const LAS bf16x8*)(Kb + key * 128 + (((2 * ks + h) ^ ((key >> 1) & 7)) << 4)); } }
                    __builtin_amdgcn_sched_barrier(0);
#pragma unroll
                    for (int j2 = 0; j2 < 2; ++j2) { const int t5 = 2 * tp + j2; if (t5 < 5) { S[t5] = zero16();
#pragma unroll
                        for (int ks = 0; ks < 4; ++ks) S[t5] = __builtin_amdgcn_mfma_f32_32x32x16_bf16(kf[j2][ks], qf[ks], S[t5], 0, 0, 0); } }
                    __builtin_amdgcn_sched_barrier(0);
                }
                const int qi = 32 * qt + r; float mx = sink2;
                int hq = h; asm volatile("" : "+v"(hq));
#pragma unroll
                for (int t5 = 0; t5 < 5; ++t5)
#pragma unroll
                    for (int i = 0; i < 16; ++i) { const int sj = 32 * (qt + t5) + crow(i, hq), dist = qi + 128 - sj; const bool ok = (dist >= 0) && (dist < 128) && (sj >= sjmin);
                        const float v = ok ? S[t5][i] * c - slope2 * (float)dist : -INFINITY; S[t5][i] = v; mx = fmaxf(mx, v); }
                mx = xmax32(mx);
                float sum = 0.f;
#pragma unroll
                for (int t5 = 0; t5 < 5; ++t5)
#pragma unroll
                    for (int i = 0; i < 16; ++i) { const float p = __builtin_amdgcn_exp2f(S[t5][i] - mx); S[t5][i] = p; sum += p; }
                sum = xsum32(sum); sum += __builtin_amdgcn_exp2f(sink2 - mx);
                f32x16 o0 = zero16(), o1 = zero16();
#pragma unroll
                for (int t5 = 0; t5 < 5; ++t5) {
                    s16x4 tv[2][4];
#pragma unroll
                    for (int s = 0; s < 2; ++s) { const int ko = (32 * (qt + t5) + 16 * s) * 128; tv[s][0] = vtr(Vb0 + ko); tv[s][1] = vtr(Vb0 + ko + 8 * 128); tv[s][2] = vtr(Vb1 + ko); tv[s][3] = vtr(Vb1 + ko + 8 * 128); }
                    __builtin_amdgcn_sched_barrier(0);
#pragma unroll
                    for (int s = 0; s < 2; ++s) { const bf16x8 pb = pack8(S[t5], 8 * s);
                        const bf16x8 v0 = {tv[s][0][0], tv[s][0][1], tv[s][0][2], tv[s][0][3], tv[s][1][0], tv[s][1][1], tv[s][1][2], tv[s][1][3]}, v1 = {tv[s][2][0], tv[s][2][1], tv[s][2][2], tv[s][2][3], tv[s][3][0], tv[s][3][1], tv[s][3][2], tv[s][3][3]};
                        o0 = __builtin_amdgcn_mfma_f32_32x32x16_bf16(v0, pb, o0, 0, 0, 0); o1 = __builtin_amdgcn_mfma_f32_32x32x16_bf16(v1, pb, o1, 0, 0, 0); }
                    __builtin_amdgcn_sched_barrier(0);
                }
                const float inv = __builtin_amdgcn_rcpf(sum);
                o0 = o0 * inv; o1 = o1 * inv;
                float sq = sumsq16(o0) + sumsq16(o1); sq = xsum32(sq);
                if (h == 0) ssqS[w * 64 + qi] = sq;
                pack_ot(HS[qt], o0, o1);
                __builtin_amdgcn_sched_barrier(0);
            }
        }
        }
        }
        __syncthreads();
        if (!(var & 16)) {
            const int hm = w >> 1, qm = 32 * (w & 1) + r;
            const float totm = (ssqM[qm] + ssqM[64 + qm]) + (ssqM[128 + qm] + ssqM[192 + qm]);
            LAS unsigned char* wb = lds + w * 12288;
            store_pk_lds(wb, mixed + (tok0 + 32 * (w & 1)) * DM + 768 + hm * 64, HM, __builtin_amdgcn_rsqf(totm * (1.0f / 256.0f) + EPS), r, h, lane);
#pragma unroll
            for (int qt = 0; qt < 2; ++qt) { const int q = 32 * qt + r; float tot = 0.f;
#pragma unroll
                for (int hh = 0; hh < 8; ++hh) tot += ssqS[hh * 64 + q];
                store_pk_lds(wb + 4096 * (qt + 1), mixed + (tok0 + 32 * qt) * DM + 256 + w * 64, HS[qt], __builtin_amdgcn_rsqf(tot * (1.0f / 512.0f) + EPS), r, h, lane); }
        }
        asm volatile("s_waitcnt lgkmcnt(0)" ::: "memory"); __builtin_amdgcn_s_barrier(); asm volatile("" ::: "memory");
    }
}


#define XB_TMO      128
#define XB_XCNT(j)  (256  + 64 * (j))
#define XB_XSUB(j)  (1280 + 64 * (j))
#define XB_XGEN(j)  (2304 + 64 * (j))
#define XB_TOP      3328
#define XB_TOPGEN   3392
#define XCD_BAR_WORDS 3456
#define XB_SPIN_CAP (1u << 18)

__device__ __forceinline__ unsigned xb_ld(unsigned* p)              { return __hip_atomic_load(p, __ATOMIC_RELAXED, __HIP_MEMORY_SCOPE_AGENT); }
__device__ __forceinline__ unsigned xb_add(unsigned* p, unsigned v) { return __hip_atomic_fetch_add(p, v, __ATOMIC_RELAXED, __HIP_MEMORY_SCOPE_AGENT); }
__device__ __forceinline__ unsigned xb_xcc_id() { return (unsigned)__builtin_amdgcn_s_getreg((3 << 11) | 20) & 0xFu; }
#define XB_SPIN(cond, bar) do { unsigned _sp = 0; while (cond) { __builtin_amdgcn_s_sleep(1); \
    if ((++_sp & 255u) == 0u) { if (xb_ld(&(bar)[XB_TMO])) break; if (_sp > XB_SPIN_CAP) { atomicAdd(&(bar)[XB_TMO], 1u); break; } } } } while (0)

struct XcdBarrier {
    unsigned* bar; unsigned x;
    volatile LAS unsigned* st;
};

__device__ __forceinline__ XcdBarrier xcd_barrier_post(unsigned* bar, volatile LAS unsigned* st) {
    XcdBarrier b; b.bar = bar; b.x = xb_xcc_id(); b.st = st;
    if (threadIdx.x == 0) (void)xb_add(&bar[XB_XCNT(b.x)], 1u);
    return b;
}
__device__ __forceinline__ void xcd_barrier_complete(unsigned* bar, unsigned x, unsigned& nloc, unsigned& nx) {
    const unsigned G = gridDim.x * gridDim.y * gridDim.z;
    unsigned sum, cnt, mine, sp = 0u;
    for (;;) {
        sum = 0u; cnt = 0u; mine = 0u;
#pragma unroll
        for (unsigned j = 0; j < 16; ++j) { const unsigned c = xb_ld(&bar[XB_XCNT(j)]); sum += c; cnt += (c > 0u) ? 1u : 0u; mine = (j == x) ? c : mine; }
        if (sum == G) break;
        __builtin_amdgcn_s_sleep(1);
        if ((++sp & 255u) == 0u) { if (xb_ld(&bar[XB_TMO])) break; if (sp > XB_SPIN_CAP) { atomicAdd(&bar[XB_TMO], 1u); break; } }
    }
    nloc = mine > 0u ? mine : 1u; nx = cnt > 0u ? cnt : 1u;
}

__device__ __forceinline__ void xcd_barrier(const XcdBarrier& b) {
    asm volatile("s_waitcnt vmcnt(0)" ::: "memory");
    __syncthreads();
    if (threadIdx.x == 0) {
        unsigned* bar = b.bar;
        __builtin_amdgcn_s_waitcnt(0);
        unsigned nloc = b.st[0], nx = b.st[1];
        if (nloc == 0u) { xcd_barrier_complete(bar, b.x, nloc, nx); b.st[0] = nloc; b.st[1] = nx; }
        const unsigned old = xb_add(&bar[XB_XSUB(b.x)], 1u);
        const unsigned gen = old / nloc;
        if (old + 1u == (gen + 1u) * nloc) {
            __builtin_amdgcn_fence(__ATOMIC_RELEASE, "agent");
            asm volatile("s_waitcnt vmcnt(0)" ::: "memory");
            const unsigned og = xb_add(&bar[XB_TOP], 1u);
            const unsigned tg = og / nx;
            if (og + 1u == (tg + 1u) * nx) xb_add(&bar[XB_TOPGEN], 1u);
            else XB_SPIN(xb_ld(&bar[XB_TOPGEN]) == tg, bar);
            __builtin_amdgcn_fence(__ATOMIC_ACQUIRE, "agent");
            xb_add(&bar[XB_XGEN(b.x)], 1u);
            asm volatile("s_waitcnt vmcnt(0)" ::: "memory");
        } else {
            XB_SPIN(xb_ld(&bar[XB_XGEN(b.x)]) == gen, bar);
            __builtin_amdgcn_fence(__ATOMIC_ACQUIRE, "agent");
            asm volatile("s_waitcnt vmcnt(0)" ::: "memory");
        }
    }
    __syncthreads();
}


__global__ void __launch_bounds__(512) fwd_kernel(Args a) {
    extern __shared__ __attribute__((aligned(16))) unsigned char lds_raw[];
    LAS unsigned char* lds = (LAS unsigned char*)lds_raw;
    if (threadIdx.x < 16) ((LAS unsigned*)(lds + LDS_BARW))[threadIdx.x] = 0u;
    __syncthreads();
    XcdBarrier bar; bar.bar = (unsigned*)(a.ws + WS_CTL); bar.x = 0; bar.st = nullptr;
    if (a.coop) bar = xcd_barrier_post((unsigned*)(a.ws + WS_CTL), (volatile LAS unsigned*)(lds + LDS_BARW));
    int ph0 = a.ph_lo;
    if (ph0 == 0) {
        int tid = threadIdx.x; asm volatile("" : "+v"(tid));
        const int lane = tid & 63, wave = __builtin_amdgcn_readfirstlane(tid >> 6), gw = (int)blockIdx.x * 8 + wave, NGW = (int)gridDim.x * 8;
        prologue(a, lds, gw, NGW, wave, lane);
        ph0 = 1;
        if (ph0 < a.ph_hi) { if (a.coop == 2) cg::this_grid().sync(); else if (a.coop) xcd_barrier(bar); else __syncthreads(); }
    }
    for (int ph = ph0; ph < a.ph_hi; ++ph) {
      const int reps = 1 + MK_DUPN * ((a.dup >> ph) & 1);
      for (int rep = 0; rep < reps; ++rep) {
        if (MK_STAG > 0 && (ph == 1 || ph == 6 || ph == 8 || ph == 13) && (blockIdx.x & 1)) {
#pragma unroll 1
            for (int i = 0; i < MK_STAG; ++i) __builtin_amdgcn_s_sleep(127); }
        int tid = threadIdx.x; asm volatile("" : "+v"(tid));
        int G = gridDim.x, bid = blockIdx.x; asm volatile("" : "+s"(G), "+s"(bid));
        size_t wz = 0; asm volatile("" : "+s"(wz));
        unsigned char* ws = a.ws + wz;
        const int lane = tid & 63, wave = __builtin_amdgcn_readfirstlane(tid >> 6), gw = bid * 8 + wave, NGW = G * 8;
        float* ss = (float*)(ws + WS_SS); bf16* hb = (bf16*)(ws + WS_HB); bf16* act = (bf16*)(ws + WS_ACT); bf16* Pb = (bf16*)(ws + WS_P); bf16* mixed = (bf16*)(ws + WS_MIXED);
        if (ph == NPHASE - 1) final_norm(a, gw, NGW, lane);
        else {
            const int l = (ph - 1) / 7, s = (ph - 1) % 7;
            unsigned char* wl = ws + WS_W0 + (size_t)l * WS_WL;
            if (s == 0 || s == 5) {
                pg8::Gemm g{hb, (const bf16*)(wl + (s == 0 ? OFF_WUP1 : OFF_WUP2)), NTOK, 2 * DFF, DM}; pg8::StaticOrder S; S.init(NTOK, 2 * DFF, G, bid);
                EpiSwiglu E{act, ss, (rep + 1 < reps) ? MK_SKIPEPI : 0};
                pg8::gemm_phase<EpiSwiglu, pg8::StaticOrder, true, true>(lds, g, S, E, tid);
            } else if (s == 1 || s == 4 || s == 6) {
                const bool isout = (s == 4);
                pg8::Gemm g{isout ? mixed : act, (const bf16*)(wl + (s == 1 ? OFF_WDN1 : (s == 4 ? OFF_WOUT : OFF_WDN2))), NTOK, DM, isout ? DM : DFF}; pg8::StaticOrder S; S.init(NTOK, DM, G, bid); S.rev = MK_REV;
                EpiResid E{hb, ss, isout ? 1.0f : 0.5f};
                pg8::gemm_phase<EpiResid, pg8::StaticOrder, true, true>(lds, g, S, E, tid);
            } else if (s == 2) {
                const int ng = (l == 0) ? 3 : 1;
                if (MK_WSTAG > 0 && G == 256 && bid >= (l == 0 ? 160 : 128)) {
#pragma unroll 1
                    for (int i = 0; i < MK_WSTAG; ++i) __builtin_amdgcn_s_sleep(127); }
                for (int gi = 0; gi < ng; ++gi) {
                    pg8::Gemm g; pg8::StaticOrder S; EpiScaleBf16 E;
                    if (gi == 0) { g = pg8::Gemm{hb, (const bf16*)(wl + OFF_WIN), NTOK, DIN, DM}; S.init(NTOK, DIN, G, bid); E = EpiScaleBf16{Pb, DIN, ss}; }
                    else if (gi == 1) { g = pg8::Gemm{(const bf16*)(ws + WS_MEMN), (const bf16*)(ws + WS_WMK), NMEM, 512, DM}; S.init(NMEM, 512, G, (bid + 128) % G); E = EpiScaleBf16{(bf16*)(ws + WS_MK), 512, nullptr}; }
                    else { g = pg8::Gemm{(const bf16*)(ws + WS_WMV), (const bf16*)(ws + WS_MEMNP), 512, NMEM, DM}; S.init(512, NMEM, G, (bid + 112) % G); E = EpiScaleBf16{(bf16*)(ws + WS_VT), NMEM, nullptr}; }
                    pg8::gemm_phase<EpiScaleBf16, pg8::StaticOrder, false, true>(lds, g, S, E, tid);
                }
            } else {
                mixer_phase(lds, Pb, (const bf16*)(ws + WS_MK), (const bf16*)(ws + WS_VT), a.conv_w + l * 768, a.sinks + l * 8, mixed, l, G, bid, tid, (rep + 1 < reps) ? MK_MIXVAR : 0);
            }
        }
        if (ph + 1 < a.ph_hi || rep + 1 < reps) { if (a.coop == 2) cg::this_grid().sync();
          else if (a.coop) xcd_barrier(bar); else __syncthreads(); }
      }
    }
}

extern "C" void kernel_launch(void* const* d_in, const int* in_sizes, int n_in, void* d_out, int out_size, void* d_ws, size_t ws_size, hipStream_t stream) {
    static int grid = 0;
    if (grid == 0) {
        if (n_in != 17 || in_sizes[0] != NTOK * DM || out_size != NTOK * DM || ws_size < WS_TOTAL) { fprintf(stderr, "kernel_launch: unexpected shapes / workspace (n_in %d, ws %zu)\n", n_in, ws_size); grid = -1; return; }
        int dev = 0, cus = 0, per_cu = 0;
        hipGetDevice(&dev); hipDeviceGetAttribute(&cus, hipDeviceAttributeMultiprocessorCount, dev);
        if (hipFuncSetAttribute((const void*)fwd_kernel, hipFuncAttributeMaxDynamicSharedMemorySize, LDS_BYTES) != hipSuccess) { fprintf(stderr, "kernel_launch: hipFuncSetAttribute failed\n"); grid = -1; return; }
        if (hipOccupancyMaxActiveBlocksPerMultiprocessor(&per_cu, (const void*)fwd_kernel, 512, LDS_BYTES) != hipSuccess || per_cu < 1) { fprintf(stderr, "kernel_launch: occupancy query says %d\n", per_cu); per_cu = 1; }
        (void)hipGetLastError();
        grid = cus * 1;
        if (grid <= 0) grid = 256;
    }
    if (grid < 0) return;
    if (hipMemsetAsync((char*)d_ws + WS_CTL, 0, CTL_BYTES, stream) != hipSuccess) { fprintf(stderr, "kernel_launch: memset of the barrier words failed\n"); return; }
    Args a{};
    const float** ap = (const float**)&a;
    for (int i = 0; i < 17; ++i) ap[i] = (const float*)d_in[i];
    a.out = (float*)d_out; a.ws = (unsigned char*)d_ws;
#if MK_ONE_LAUNCH
    a.ph_lo = 0; a.ph_hi = NPHASE; a.coop = 1; a.dup = MK_DUP;
    void* args[] = {&a};
    hipError_t e = hipLaunchCooperativeKernel((const void*)fwd_kernel, dim3(grid), dim3(512), args, LDS_BYTES, stream);
    if (e != hipSuccess) fprintf(stderr, "cooperative launch failed: %s (grid %d)\n", hipGetErrorString(e), grid);
#else
    for (int ph = 0; ph < NPHASE; ++ph) {
        a.ph_lo = ph; a.ph_hi = ph + 1; a.coop = 0;
        hipLaunchKernelGGL(fwd_kernel, dim3(grid), dim3(512), LDS_BYTES, stream, a);
    }
#endif
}
```

```cpp
#include <hip/hip_runtime.h>
#include <hip/hip_cooperative_groups.h>
#include <cstdio>
#include <cstdint>
namespace cg = cooperative_groups;
#ifndef MK_ONE_LAUNCH
#define MK_ONE_LAUNCH 1
#endif
#ifndef MK_DUP
#define MK_DUP 0
#endif
#ifndef MK_SKIPEPI
#define MK_SKIPEPI 0
#endif
#ifndef MK_MIXVAR
#define MK_MIXVAR 0
#endif
#ifndef MK_DUPN
#define MK_DUPN 1
#endif
#ifndef MK_NST_UP
#define MK_NST_UP 8
#endif
#ifndef MK_NST_RES
#define MK_NST_RES 0
#endif
#ifndef MK_NST_SC
#define MK_NST_SC 0
#endif
#ifndef MK_REV
#define MK_REV 1
#endif

#ifndef MK_FUSE_FINAL
#define MK_FUSE_FINAL 0
#endif

#ifndef MK_DEFER
#define MK_DEFER 0
#endif

#ifndef MK_STAG
#define MK_STAG 4
#endif

#ifndef MK_WSTAG
#define MK_WSTAG 4
#endif

#ifndef MK_STAG4
#define MK_STAG4 1
#endif

#ifndef MK_STAGR
#define MK_STAGR 0
#endif
namespace pg8 {
#define PG8_LAS __attribute__((address_space(3)))
typedef unsigned short bf16_t;
typedef short bf16x8 __attribute__((ext_vector_type(8)));
typedef float f32x4 __attribute__((ext_vector_type(4)));
typedef unsigned u32x4 __attribute__((ext_vector_type(4)));
constexpr int BM = 256, BK = 64, HALF = 128, HTB = HALF * BK * 2  , STAGE_BYTES = 8 * HTB, NXCD = 8, WGM = 8;

__host__ __device__ __forceinline__ int lds_byte(int r, int c) { const int st = (r >> 4) * 2 + (c >> 5), rr = r & 15, cc = c & 31, ob = rr * 64 + cc * 2; return st * 1024 + (ob ^ (((ob >> 9) & 1) << 5)); }
__host__ __device__ __forceinline__ void stage_rc(int b, int& R, int& C) { const int st = b / 1024, sb = b % 1024, swz = sb ^ (((sb >> 9) & 1) << 5); R = (st >> 1) * 16 + swz / 64; C = (st & 1) * 32 + (swz % 64) / 2; }
__host__ __device__ __forceinline__ int perm32(int rho) { const int n = rho >> 4, i = rho & 15; return 8 * (i >> 2) + 4 * n + (i & 3); }

struct Unit { int pm, pn; };
struct Gemm { const bf16_t* A; const bf16_t* Bt; int M, N, K; };

struct StaticOrder {
    int nM, nN, nwg, G, c; int rev = 0;
    __host__ __device__ void init(int M, int N, int G_, int c_) { nM = M / BM; nN = N / BM; nwg = nM * nN; G = G_; c = c_; }
    __host__ __device__ bool next(int i, Unit& u) const {
        const long L = (long)i * G + c; if (L >= nwg) return false;
        int wgid = rev ? (nwg - 1 - (int)L) : (int)L; { const int q = nwg / NXCD, r = nwg % NXCD, xcd = wgid % NXCD, off = wgid / NXCD; wgid = (xcd < r ? xcd * (q + 1) : r * (q + 1) + (xcd - r) * q) + off; }
        const int nig = WGM * nN, gid = wgid / nig, fm = gid * WGM, gsz = (nM - fm) < WGM ? (nM - fm) : WGM;
        u.pm = fm + ((wgid % nig) % gsz); u.pn = (wgid % nig) / gsz; return true;
    }
    __device__ __forceinline__ void a_ready(const Unit&) const {}
    __device__ __forceinline__ void done(const Unit&) const {}
};

__device__ __forceinline__ unsigned cvt_pk_bf16(float lo, float hi) { unsigned r; asm volatile("v_cvt_pk_bf16_f32 %0, %1, %2" : "=v"(r) : "v"(lo), "v"(hi)); return r; }
typedef float f32x2 __attribute__((ext_vector_type(2)));

template <class Epi, class Sched, bool ALIGN_EPI = false, bool SP2 = false>
__device__ __forceinline__ void gemm_phase(PG8_LAS unsigned char* lds, const Gemm g, const Sched& S, const Epi& E, const int tid) {
    const int wid = __builtin_amdgcn_readfirstlane(tid >> 6), lane = tid & 63, wr = wid >> 2, wc = wid & 3, fr = lane & 15, fq = lane >> 4;
    const int K = g.K, nt = K / BK;
    unsigned voffA[2], voffB[2];
#pragma unroll
    for (int i = 0; i < 2; ++i) { int R, C; stage_rc(tid * 16 + i * 8192, R, C); const int Rb = Epi::PERM ? ((R & ~31) + perm32(R & 31)) : R;
        voffA[i] = (unsigned)(R * K + C) * 2u; voffB[i] = (unsigned)(Rb * K + C) * 2u; }
    const size_t kstep = (size_t)(BK * 2);
    const size_t hstep = (size_t)HALF * K * 2;
    const size_t tstep = 2 * hstep;
    const unsigned ldsw = (unsigned)wid * 1024u;
    const int aoff = lds_byte(wr * 64 + fr, fq * 8), boff = lds_byte(wc * 32 + fr, fq * 8);
#define PG8_SA(b, h) (((b) * 2 + (h)) * HTB)
#define PG8_SB(b, h) ((4 + (b) * 2 + (h)) * HTB)
#define PG8_STAGE(bufoff, gbase, voff) do { _Pragma("unroll") for (int _i = 0; _i < 2; ++_i) \
        __builtin_amdgcn_global_load_lds((const unsigned*)((const char*)(gbase) + (voff)[_i]), (PG8_LAS unsigned*)(lds + (bufoff) + ldsw + _i * 8192), 16, 0, 0); } while (0)
#define PG8_LDA(dst, b, h) do { _Pragma("unroll") for (int m = 0; m < 4; ++m) _Pragma("unroll") for (int k = 0; k < 2; ++k) dst[m][k] = *(const PG8_LAS bf16x8*)(lds + PG8_SA(b, h) + aoff + m * 2048 + k * 1024); } while (0)
#define PG8_LDB(dst, b, h) do { _Pragma("unroll") for (int n = 0; n < 2; ++n) _Pragma("unroll") for (int k = 0; k < 2; ++k) dst[n][k] = *(const PG8_LAS bf16x8*)(lds + PG8_SB(b, h) + boff + n * 2048 + k * 1024); } while (0)
#define PG8_MMA(ai, bj, At, Bt) do { __builtin_amdgcn_s_setprio(1); _Pragma("unroll") for (int m = 0; m < 4; ++m) _Pragma("unroll") for (int n = 0; n < 2; ++n) _Pragma("unroll") for (int k = 0; k < 2; ++k) \
        acc[ai][bj][m][n] = __builtin_amdgcn_mfma_f32_16x16x32_bf16(Bt[n][k], At[m][k], acc[ai][bj][m][n], 0, 0, 0); __builtin_amdgcn_s_setprio(0); } while (0)
#define PG8_WAIT_V(n) asm volatile("s_waitcnt vmcnt(" #n ")" ::: "memory")
#define PG8_WAIT_VR(rx) asm volatile("s_cmp_eq_u32 %0, 0\n\ts_cbranch_scc1 2\n\ts_waitcnt vmcnt(%1)\n\ts_branch 1\n\ts_waitcnt vmcnt(8)" :: "s"(rx), "n"(8 + Epi::NST) : "memory", "scc")
#define PG8_WAIT_L(n) asm volatile("s_waitcnt lgkmcnt(" #n ")" ::: "memory")
#define PG8_BAR __builtin_amdgcn_s_barrier()
#define PG8_SCHED __builtin_amdgcn_sched_barrier(0)
    Unit cur, nxt; int ui = 0;
    if (!S.next(0, cur)) return;
    f32x4 acc[2][2][4][2];
#pragma unroll
    for (int a = 0; a < 2; ++a)
#pragma unroll
        for (int b = 0; b < 2; ++b)
#pragma unroll
            for (int m = 0; m < 4; ++m)
#pragma unroll
                for (int n = 0; n < 2; ++n) acc[a][b][m][n] = (f32x4){0.f, 0.f, 0.f, 0.f};
    bf16x8 At[4][2], B0[2][2], B1[2][2];
    const char* cA = (const char*)g.A + (size_t)cur.pm * tstep; const char* cB = (const char*)g.Bt + (size_t)cur.pn * tstep;
    S.a_ready(cur);
    if constexpr (SP2) {
        PG8_STAGE(PG8_SB(0, 0), cB, voffB); PG8_STAGE(PG8_SB(0, 1), cB + hstep, voffB); PG8_STAGE(PG8_SA(0, 0), cA, voffA); PG8_STAGE(PG8_SA(0, 1), cA + hstep, voffA);
        if (wr == 1) PG8_BAR;
        PG8_WAIT_V(2); PG8_BAR;
        PG8_STAGE(PG8_SB(1, 0), cB + kstep, voffB); PG8_STAGE(PG8_SA(1, 0), cA + kstep, voffA); PG8_STAGE(PG8_SB(1, 1), cB + hstep + kstep, voffB);
        PG8_WAIT_V(6); PG8_BAR;
    } else {
        PG8_STAGE(PG8_SB(0, 0), cB, voffB); PG8_STAGE(PG8_SA(0, 0), cA, voffA); PG8_STAGE(PG8_SB(0, 1), cB + hstep, voffB); PG8_STAGE(PG8_SA(0, 1), cA + hstep, voffA);
        if (wr == 1) PG8_BAR;
        PG8_WAIT_V(4); PG8_BAR;
        PG8_STAGE(PG8_SB(1, 0), cB + kstep, voffB); PG8_STAGE(PG8_SA(1, 0), cA + kstep, voffA); PG8_STAGE(PG8_SB(1, 1), cB + hstep + kstep, voffB);
        PG8_WAIT_V(6); PG8_BAR;
    }
    for (;;) {
        const bool has_next = S.next(ui + 1, nxt);
        const char* nA = has_next ? (const char*)g.A + (size_t)nxt.pm * tstep : cA; const char* nB = has_next ? (const char*)g.Bt + (size_t)nxt.pn * tstep : cB;
        for (int t = 0; t < nt; t += 2) {
            const bool last = (t == nt - 2);
            const char* a1 = cA + (size_t)(t + 1) * kstep;
            const char* a2 = last ? nA : cA + (size_t)(t + 2) * kstep; const char* b2 = last ? nB : cB + (size_t)(t + 2) * kstep;
            const char* a3 = a2 + kstep; const char* b3 = b2 + kstep;
            if (last && has_next) S.a_ready(nxt);
            if constexpr (SP2) {
            PG8_LDB(B0, 0, 0); PG8_LDB(B1, 0, 1); PG8_SCHED; PG8_LDA(At, 0, 0); PG8_STAGE(PG8_SA(1, 1), a1 + hstep, voffA);
            PG8_WAIT_V(8); PG8_WAIT_L(0); PG8_BAR; PG8_MMA(0, 0, At, B0); PG8_MMA(0, 1, At, B1); PG8_BAR; PG8_SCHED;
            PG8_LDA(At, 0, 1); PG8_STAGE(PG8_SB(0, 0), b2, voffB); PG8_STAGE(PG8_SB(0, 1), b2 + hstep, voffB); PG8_STAGE(PG8_SA(0, 0), a2, voffA);
            PG8_WAIT_V(8); PG8_WAIT_L(0); PG8_BAR; PG8_MMA(1, 0, At, B0); PG8_MMA(1, 1, At, B1); PG8_BAR; PG8_SCHED;
            PG8_LDB(B0, 1, 0); PG8_LDB(B1, 1, 1); PG8_SCHED; PG8_LDA(At, 1, 0); PG8_STAGE(PG8_SA(0, 1), a2 + hstep, voffA);
            PG8_WAIT_V(8); PG8_WAIT_L(0); PG8_BAR; PG8_MMA(0, 0, At, B0); PG8_MMA(0, 1, At, B1); PG8_BAR; PG8_SCHED;
            PG8_LDA(At, 1, 1); PG8_STAGE(PG8_SB(1, 0), b3, voffB); PG8_STAGE(PG8_SB(1, 1), b3 + hstep, voffB); PG8_STAGE(PG8_SA(1, 0), a3, voffA);
            PG8_WAIT_V(8); PG8_WAIT_L(0); PG8_BAR; PG8_MMA(1, 0, At, B0); PG8_MMA(1, 1, At, B1); PG8_BAR; PG8_SCHED;
            } else {
            PG8_LDB(B0, 0, 0); PG8_SCHED; PG8_LDA(At, 0, 0); PG8_STAGE(PG8_SA(1, 1), a1 + hstep, voffA);
            PG8_WAIT_L(8); PG8_BAR; PG8_WAIT_L(0); PG8_MMA(0, 0, At, B0); PG8_BAR; PG8_SCHED;
            PG8_LDB(B1, 0, 1); PG8_STAGE(PG8_SB(0, 0), b2, voffB);
            PG8_BAR; PG8_WAIT_L(0); PG8_MMA(0, 1, At, B1); PG8_BAR;
            PG8_LDA(At, 0, 1); PG8_STAGE(PG8_SA(0, 0), a2, voffA);
            PG8_BAR; PG8_WAIT_L(0); PG8_MMA(1, 0, At, B0); PG8_BAR; PG8_SCHED;
            PG8_STAGE(PG8_SB(0, 1), b2 + hstep, voffB);
            PG8_WAIT_V(6); PG8_BAR; PG8_MMA(1, 1, At, B1); PG8_BAR;
            PG8_LDB(B0, 1, 0); PG8_SCHED; PG8_LDA(At, 1, 0); PG8_STAGE(PG8_SA(0, 1), a2 + hstep, voffA);
            PG8_WAIT_L(8); PG8_BAR; PG8_WAIT_L(0); PG8_MMA(0, 0, At, B0); PG8_BAR; PG8_SCHED;
            PG8_LDB(B1, 1, 1); PG8_STAGE(PG8_SB(1, 0), b3, voffB);
            PG8_BAR; PG8_WAIT_L(0); PG8_MMA(0, 1, At, B1); PG8_BAR;
            PG8_LDA(At, 1, 1); PG8_STAGE(PG8_SA(1, 0), a3, voffA);
            PG8_BAR; PG8_WAIT_L(0); PG8_MMA(1, 0, At, B0); PG8_BAR; PG8_SCHED;
            PG8_STAGE(PG8_SB(1, 1), b3 + hstep, voffB);
            PG8_WAIT_V(6); PG8_BAR; PG8_MMA(1, 1, At, B1); PG8_BAR;
            }
        }
        if constexpr (ALIGN_EPI) { if (wr == 0) PG8_BAR; }
        if constexpr (!Epi::AFTER_DRAIN) { E(acc, cur, wr, wc, fr, fq); S.done(cur); }
        if (!has_next) break;
#pragma unroll
        for (int a = 0; a < 2; ++a)
#pragma unroll
            for (int b = 0; b < 2; ++b)
#pragma unroll
                for (int m = 0; m < 4; ++m)
#pragma unroll
                    for (int n = 0; n < 2; ++n) acc[a][b][m][n] = (f32x4){0.f, 0.f, 0.f, 0.f};
        cur = nxt; cA = nA; cB = nB; ++ui;
        if constexpr (ALIGN_EPI) { if (wr == 1) PG8_BAR; }
    }
    PG8_WAIT_V(0);
    if constexpr (!ALIGN_EPI) { if (wr == 0) PG8_BAR; }
    PG8_BAR;
    if constexpr (Epi::AFTER_DRAIN) { E.fused(acc, cur, wr, wc, fr, fq, lds, wid, lane); S.done(cur); }
#undef PG8_SA
#undef PG8_SB
#undef PG8_STAGE
#undef PG8_LDA
#undef PG8_LDB
#undef PG8_MMA
#undef PG8_WAIT_V
#undef PG8_WAIT_VR
#undef PG8_WAIT_L
#undef PG8_BAR
#undef PG8_SCHED
}
}

#define LAS __attribute__((address_space(3)))
typedef unsigned short bf16;
typedef short bf16x8 __attribute__((ext_vector_type(8)));
typedef short s16x4 __attribute__((ext_vector_type(4)));
typedef float f32x4 __attribute__((ext_vector_type(4)));
typedef float f32x2 __attribute__((ext_vector_type(2)));
typedef float f32x16 __attribute__((ext_vector_type(16)));
typedef unsigned u32x4 __attribute__((ext_vector_type(4)));
typedef unsigned u32x2 __attribute__((ext_vector_type(2)));
typedef __bf16 bf16x2_t __attribute__((ext_vector_type(2)));

constexpr int NTOK = 32768, DM = 1024, DFF = 2816, DIN = 1792, SEQ = 4096, NBATCH = 8, MEML = 256, NMEM = NBATCH * MEML;
constexpr float EPS = 1e-6f;
constexpr float LOG2E = 1.4426950408889634f;
constexpr size_t MiB = (size_t)1 << 20;
constexpr size_t WS_SS = 0, WS_MK = 2 * MiB, WS_VT = 4 * MiB, WS_WMK = 6 * MiB, WS_WMV = 7 * MiB, WS_MEMN = 8 * MiB, WS_MEMNP = 12 * MiB;
constexpr size_t WS_W0 = 16 * MiB, WS_WL = 40 * MiB;
constexpr size_t OFF_WUP1 = 0, OFF_WDN1 = OFF_WUP1 + (size_t)5632 * 1024 * 2, OFF_WIN = OFF_WDN1 + (size_t)1024 * 2816 * 2, OFF_WOUT = OFF_WIN + (size_t)1792 * 1024 * 2,
                 OFF_WUP2 = OFF_WOUT + (size_t)1024 * 1024 * 2, OFF_WDN2 = OFF_WUP2 + (size_t)5632 * 1024 * 2, OFF_WEND = OFF_WDN2 + (size_t)1024 * 2816 * 2;
static_assert(OFF_WEND <= WS_WL, "weight block");
constexpr size_t WS_HB = 96 * MiB, WS_ACT = 160 * MiB, WS_P = WS_ACT, WS_MIXED = WS_ACT + 112 * MiB, WS_END = WS_ACT + 176 * MiB;
constexpr size_t WS_CTL = WS_END, CTL_BYTES = 16384, WS_TOTAL = WS_END + CTL_BYTES;
constexpr int LDS_BYTES = 147456, LDS_BARW = LDS_BYTES - 64;
constexpr int NPHASE = 16;

__device__ __forceinline__ unsigned cvtpk(float lo, float hi) { f32x2 v = {lo, hi}; bf16x2_t b = __builtin_convertvector(v, bf16x2_t); return __builtin_bit_cast(unsigned, b); }
__device__ __forceinline__ void unpack8(const u32x4 w, float (&f)[8]) {
    f[0] = __uint_as_float(w.x << 16); f[1] = __uint_as_float(w.x & 0xffff0000u); f[2] = __uint_as_float(w.y << 16); f[3] = __uint_as_float(w.y & 0xffff0000u);
    f[4] = __uint_as_float(w.z << 16); f[5] = __uint_as_float(w.z & 0xffff0000u); f[6] = __uint_as_float(w.w << 16); f[7] = __uint_as_float(w.w & 0xffff0000u);
}
__device__ __forceinline__ float xsum32(float v) { const auto rr = __builtin_amdgcn_permlane32_swap(__float_as_uint(v), __float_as_uint(v), false, false); return __uint_as_float(rr[0]) + __uint_as_float(rr[1]); }
__device__ __forceinline__ float xmax32(float v) { const auto rr = __builtin_amdgcn_permlane32_swap(__float_as_uint(v), __float_as_uint(v), false, false); return fmaxf(__uint_as_float(rr[0]), __uint_as_float(rr[1])); }
__device__ __forceinline__ float xsum16(float v) { const auto rr = __builtin_amdgcn_permlane16_swap(__float_as_uint(v), __float_as_uint(v), false, false); return __uint_as_float(rr[0]) + __uint_as_float(rr[1]); }
__device__ __forceinline__ float wave_sum(float v) {
#pragma unroll
    for (int o = 1; o < 64; o <<= 1) v += __shfl_xor(v, o);
    return v;
}
__device__ __forceinline__ float row_rstd(const float* ss, int row) {
    const f32x4* p = (const f32x4*)(ss + (size_t)row * 16);
    const f32x4 a = p[0], b = p[1], c = p[2], d = p[3];
    const float s = (((a.x + a.y) + (a.z + a.w)) + ((b.x + b.y) + (b.z + b.w))) + (((c.x + c.y) + (c.z + c.w)) + ((d.x + d.y) + (d.z + d.w)));
    return __builtin_amdgcn_rsqf(s * (1.0f / 1024.0f) + EPS);
}
__device__ __forceinline__ void rows_rstd(const float* ss, int row0, int fq, float (&r)[8]) {
    f32x4 p[8];
#pragma unroll
    for (int i = 0; i < 8; ++i) p[i] = *(const f32x4*)(ss + (size_t)(row0 + (i >> 2) * 128 + (i & 3) * 16) * 16 + 4 * fq);
#pragma unroll
    for (int i = 0; i < 8; ++i) { float t = (p[i].x + p[i].y) + (p[i].z + p[i].w); t = xsum16(t); t = xsum32(t); r[i] = __builtin_amdgcn_rsqf(t * (1.0f / 1024.0f) + EPS); }
}
__device__ __forceinline__ float silu_f(float x) { return x * __builtin_amdgcn_rcpf(1.0f + __builtin_amdgcn_exp2f(-x * LOG2E)); }

struct EpiSwiglu {
    static constexpr bool PERM = true, AFTER_DRAIN = false;
    bf16* O; const float* ss; int skip;
    __device__ __forceinline__ void operator()(const pg8::f32x4 (&acc)[2][2][4][2], const pg8::Unit& u, int wr, int wc, int fr, int fq) const {
        if (skip == 1) return;
        const int row0 = u.pm * 256 + wr * 64 + fr, col0 = u.pn * 128 + wc * 32 + 8 * fq;
        float rr[8];
        if (skip == 2) {
#pragma unroll
            for (int i = 0; i < 8; ++i) rr[i] = 1.0f; } else rows_rstd(ss, row0, fq, rr);
#pragma unroll
        for (int ai = 0; ai < 2; ++ai)
#pragma unroll
            for (int m = 0; m < 4; ++m) {
                const int row = row0 + ai * 128 + m * 16; const float r = rr[ai * 4 + m];
                const f32x4 g0 = acc[ai][0][m][0] * r, g1 = acc[ai][0][m][1] * r, u0 = acc[ai][1][m][0] * r, u1 = acc[ai][1][m][1] * r;
                u32x4 w;
                if (skip == 2) { w.x = cvtpk(g0[0] * u0[0], g0[1] * u0[1]); w.y = cvtpk(g0[2] * u0[2], g0[3] * u0[3]); w.z = cvtpk(g1[0] * u1[0], g1[1] * u1[1]); w.w = cvtpk(g1[2] * u1[2], g1[3] * u1[3]); }
                else {
                w.x = cvtpk(silu_f(g0[0]) * u0[0], silu_f(g0[1]) * u0[1]); w.y = cvtpk(silu_f(g0[2]) * u0[2], silu_f(g0[3]) * u0[3]);
                w.z = cvtpk(silu_f(g1[0]) * u1[0], silu_f(g1[1]) * u1[1]); w.w = cvtpk(silu_f(g1[2]) * u1[2], silu_f(g1[3]) * u1[3]); }
                if (skip != 3 || (w.x == 0x7fc1a5a5u && w.y == 0x12345678u)) *(u32x4*)(O + (size_t)row * DFF + col0) = w;
            }
    }
};
struct EpiResid {
    static constexpr bool PERM = true, AFTER_DRAIN = false;
    bf16* hb; float* ss; float scale;
    __device__ __forceinline__ void operator()(const pg8::f32x4 (&acc)[2][2][4][2], const pg8::Unit& u, int wr, int wc, int fr, int fq) const {
        const int row0 = u.pm * 256 + wr * 64 + fr, col0 = u.pn * 256 + wc * 32 + 8 * fq;
        u32x4 bv[4][2];
#pragma unroll
        for (int m = 0; m < 4; ++m)
#pragma unroll
            for (int bj = 0; bj < 2; ++bj) bv[m][bj] = *(const u32x4*)(hb + (size_t)(row0 + m * 16) * DM + col0 + bj * 128);
        asm volatile("" ::: "memory");
#pragma unroll
        for (int ai = 0; ai < 2; ++ai)
#pragma unroll
            for (int m = 0; m < 4; ++m) {
                const int row = row0 + ai * 128 + m * 16; float sq = 0.f;
#pragma unroll
                for (int bj = 0; bj < 2; ++bj) {
                    const size_t off = (size_t)row * DM + col0 + bj * 128;
                    float b[8]; unpack8(bv[m][bj], b);
                    if (ai == 0) bv[m][bj] = *(const u32x4*)(hb + off + (size_t)128 * DM);
                    const f32x4 a0 = acc[ai][bj][m][0] * scale, a1 = acc[ai][bj][m][1] * scale;
                    const float v0 = b[0] + a0[0], v1 = b[1] + a0[1], v2 = b[2] + a0[2], v3 = b[3] + a0[3], v4 = b[4] + a1[0], v5 = b[5] + a1[1], v6 = b[6] + a1[2], v7 = b[7] + a1[3];
                    u32x4 w; w.x = cvtpk(v0, v1); w.y = cvtpk(v2, v3); w.z = cvtpk(v4, v5); w.w = cvtpk(v6, v7);
                    *(u32x4*)(hb + off) = w;
                    sq += ((v0 * v0 + v1 * v1) + (v2 * v2 + v3 * v3)) + ((v4 * v4 + v5 * v5) + (v6 * v6 + v7 * v7));
                }
                sq = xsum16(sq); sq = xsum32(sq);
                if (fq == 0) ss[(size_t)row * 16 + u.pn * 4 + wc] = sq;
            }
    }
};
struct EpiScaleBf16 {
    static constexpr bool PERM = true, AFTER_DRAIN = false;
    bf16* O; int ldc; const float* ss;
    __device__ __forceinline__ void operator()(const pg8::f32x4 (&acc)[2][2][4][2], const pg8::Unit& u, int wr, int wc, int fr, int fq) const {
        const int row0 = u.pm * 256 + wr * 64 + fr, col0 = u.pn * 256 + wc * 32 + 8 * fq;
        float rr[8];
        if (ss) rows_rstd(ss, row0, fq, rr); else {
#pragma unroll
            for (int i = 0; i < 8; ++i) rr[i] = 1.0f; }
#pragma unroll
        for (int ai = 0; ai < 2; ++ai)
#pragma unroll
            for (int m = 0; m < 4; ++m) {
                const int row = row0 + ai * 128 + m * 16; const float r = rr[ai * 4 + m];
#pragma unroll
                for (int bj = 0; bj < 2; ++bj) {
                    const f32x4 v0 = acc[ai][bj][m][0] * r, v1 = acc[ai][bj][m][1] * r;
                    u32x4 w; w.x = cvtpk(v0[0], v0[1]); w.y = cvtpk(v0[2], v0[3]); w.z = cvtpk(v1[0], v1[1]); w.w = cvtpk(v1[2], v1[3]);
                    *(u32x4*)(O + (size_t)row * ldc + col0 + bj * 128) = w;
                }
            }
    }
};

__device__ __forceinline__ void tr_item(const float* __restrict__ W, int ldw, int K, const float* __restrict__ g, bf16* __restrict__ WT, int item, int nblk, int mode, int row_off, LAS float* scr, int lane) {
    const int kb = item / nblk, nb = item - kb * nblk, k0 = 64 * kb, n0 = 32 * nb;
    int drow;
    if (mode) { const int bj = n0 / DFF, rem = n0 - bj * DFF; drow = 256 * (rem >> 7) + 128 * bj + (rem & 127); } else drow = row_off + n0;
    {
        const int kq = lane >> 3, n4 = (lane & 7) * 4; f32x4 v[8]; float gv[8];
#pragma unroll
        for (int i = 0; i < 8; ++i) { v[i] = *(const f32x4*)(W + (size_t)(k0 + kq + 8 * i) * ldw + n0 + n4); gv[i] = g ? g[k0 + kq + 8 * i] : 1.0f; }
#pragma unroll
        for (int i = 0; i < 8; ++i) { LAS float* d = scr + (kq + 8 * i) * 33 + n4; d[0] = v[i].x * gv[i]; d[1] = v[i].y * gv[i]; d[2] = v[i].z * gv[i]; d[3] = v[i].w * gv[i]; }
    }
    asm volatile("s_waitcnt lgkmcnt(0)" ::: "memory");
    const int c = lane & 7;
#pragma unroll
    for (int j = 0; j < 4; ++j) { const int n = (lane >> 3) + 8 * j; const LAS float* s = scr + (8 * c) * 33 + n;
        u32x4 o; o.x = cvtpk(s[0 * 33], s[1 * 33]); o.y = cvtpk(s[2 * 33], s[3 * 33]); o.z = cvtpk(s[4 * 33], s[5 * 33]); o.w = cvtpk(s[6 * 33], s[7 * 33]);
        *(u32x4*)(WT + (size_t)(drow + n) * K + k0 + 8 * c) = o; }
    asm volatile("s_waitcnt lgkmcnt(0)" ::: "memory");
}

struct Args { const float *x, *mem, *g_ffn1, *w_ffn1_up, *w_ffn1_down, *g_mix, *w_in, *conv_w, *sinks, *g_mem, *w_mem_kv, *g_grp, *w_out, *g_ffn2, *w_ffn2_up, *w_ffn2_down, *g_final;
              float* out; unsigned char* ws; int ph_lo, ph_hi, coop, dup; };

__device__ __forceinline__ void prologue(const Args& a, LAS unsigned char* lds, int gw, int NGW, int wave, int lane) {
    LAS float* scr = (LAS float*)(lds + wave * 16384);
    unsigned char* ws = a.ws;
    constexpr int I_UP = 16 * 176, I_DN = 44 * 32, I_IN = 16 * 56, I_OUT = 16 * 32, I_MEM = 16 * 8;
    constexpr int I_LAYER = 2 * I_UP + 2 * I_DN + I_IN + I_OUT + 2 * I_MEM;
    for (int it = gw; it < 2 * I_LAYER; it += NGW) {
        const int l = it >= I_LAYER ? 1 : 0; int r = it - l * I_LAYER;
        unsigned char* wl = ws + WS_W0 + (size_t)l * WS_WL;
        if (r < I_UP) { tr_item(a.w_ffn1_up + (size_t)l * DM * 2 * DFF, 2 * DFF, DM, a.g_ffn1 + l * DM, (bf16*)(wl + OFF_WUP1), r, 176, 1, 0, scr, lane); continue; } r -= I_UP;
        if (r < I_UP) { tr_item(a.w_ffn2_up + (size_t)l * DM * 2 * DFF, 2 * DFF, DM, a.g_ffn2 + l * DM, (bf16*)(wl + OFF_WUP2), r, 176, 1, 0, scr, lane); continue; } r -= I_UP;
        if (r < I_DN) { tr_item(a.w_ffn1_down + (size_t)l * DFF * DM, DM, DFF, nullptr, (bf16*)(wl + OFF_WDN1), r, 32, 0, 0, scr, lane); continue; } r -= I_DN;
        if (r < I_DN) { tr_item(a.w_ffn2_down + (size_t)l * DFF * DM, DM, DFF, nullptr, (bf16*)(wl + OFF_WDN2), r, 32, 0, 0, scr, lane); continue; } r -= I_DN;
        if (r < I_IN) { tr_item(a.w_in + (size_t)l * DM * DIN, DIN, DM, a.g_mix + l * DM, (bf16*)(wl + OFF_WIN), r, 56, 0, 0, scr, lane); continue; } r -= I_IN;
        if (r < I_OUT) { tr_item(a.w_out + (size_t)l * DM * DM, DM, DM, a.g_grp + l * DM, (bf16*)(wl + OFF_WOUT), r, 32, 0, 0, scr, lane); continue; } r -= I_OUT;
        if (r < I_MEM) { tr_item(a.w_mem_kv + (size_t)l * DM * 512, 512, DM, a.g_mem + l * DM, (bf16*)(ws + WS_WMK), r, 8, 0, l * 256, scr, lane); continue; } r -= I_MEM;
        tr_item(a.w_mem_kv + (size_t)l * DM * 512 + 256, 512, DM, a.g_mem + l * DM, (bf16*)(ws + WS_WMV), r, 8, 0, l * 256, scr, lane);
    }
    bf16* hb = (bf16*)(ws + WS_HB); float* ss = (float*)(ws + WS_SS);
    for (int m0 = gw; m0 < NTOK; m0 += 2 * NGW) {
        f32x4 v[2][4]; float s[2] = {0.f, 0.f};
#pragma unroll
        for (int q = 0; q < 2; ++q) { const int mr = (m0 + q * NGW < NTOK) ? m0 + q * NGW : m0; const f32x4* xr = (const f32x4*)(a.x + (size_t)mr * DM) + lane;
#pragma unroll
            for (int j = 0; j < 4; ++j) v[q][j] = xr[64 * j]; }
#pragma unroll
        for (int q = 0; q < 2; ++q) { const int m = m0 + q * NGW; if (m >= NTOK) break;
#pragma unroll
            for (int j = 0; j < 4; ++j) s[q] += (v[q][j].x * v[q][j].x + v[q][j].y * v[q][j].y) + (v[q][j].z * v[q][j].z + v[q][j].w * v[q][j].w);
            const float tot = wave_sum(s[q]);
            u32x2* o8 = (u32x2*)(hb + (size_t)m * DM) + lane;
#pragma unroll
            for (int j = 0; j < 4; ++j) { u32x2 o; o.x = cvtpk(v[q][j].x, v[q][j].y); o.y = cvtpk(v[q][j].z, v[q][j].w); o8[64 * j] = o; }
            if (lane < 16) ss[(size_t)m * 16 + lane] = lane == 0 ? tot : 0.f; }
    }
    bf16* memn = (bf16*)(ws + WS_MEMN); bf16* memnp = (bf16*)(ws + WS_MEMNP);
    for (int m = gw; m < NMEM; m += NGW) {
        const f32x4* xr = (const f32x4*)(a.mem + (size_t)m * DM) + lane; f32x4 v[4]; float s = 0.f;
#pragma unroll
        for (int j = 0; j < 4; ++j) { v[j] = xr[64 * j]; s += (v[j].x * v[j].x + v[j].y * v[j].y) + (v[j].z * v[j].z + v[j].w * v[j].w); }
        const float rstd = __builtin_amdgcn_rsqf(wave_sum(s) * (1.0f / DM) + EPS);
        const int kk = m & 15, mp = (m & ~15) + 8 * ((kk >> 2) & 1) + 4 * ((kk >> 3) & 1) + (kk & 3);
        u32x2* o8 = (u32x2*)(memn + (size_t)m * DM) + lane; u32x2* p8 = (u32x2*)(memnp + (size_t)mp * DM) + lane;
#pragma unroll
        for (int j = 0; j < 4; ++j) { u32x2 o; o.x = cvtpk(v[j].x * rstd, v[j].y * rstd); o.y = cvtpk(v[j].z * rstd, v[j].w * rstd); o8[64 * j] = o; p8[64 * j] = o; }
    }
}

__device__ __forceinline__ void final_norm(const Args& a, int gw, int NGW, int lane) {
    const float* ss = (const float*)(a.ws + WS_SS); const bf16* hb = (const bf16*)(a.ws + WS_HB);
    f32x4 gv[4];
#pragma unroll
    for (int j = 0; j < 4; ++j) gv[j] = ((const f32x4*)a.g_final)[64 * j + lane];
    for (int m0 = gw; m0 < NTOK; m0 += 2 * NGW) {
        f32x4 p[2][4]; u32x2 hv[2][4];
#pragma unroll
        for (int q = 0; q < 2; ++q) { const int m = (m0 + q * NGW < NTOK) ? m0 + q * NGW : m0; const f32x4* sp = (const f32x4*)(ss + (size_t)m * 16); const u32x2* hr = (const u32x2*)(hb + (size_t)m * DM) + lane;
#pragma unroll
            for (int j = 0; j < 4; ++j) { p[q][j] = sp[j]; hv[q][j] = hr[64 * j]; } }
#pragma unroll
        for (int q = 0; q < 2; ++q) { const int m = m0 + q * NGW; if (m >= NTOK) break;
            const float sm = (((p[q][0].x + p[q][0].y) + (p[q][0].z + p[q][0].w)) + ((p[q][1].x + p[q][1].y) + (p[q][1].z + p[q][1].w))) + (((p[q][2].x + p[q][2].y) + (p[q][2].z + p[q][2].w)) + ((p[q][3].x + p[q][3].y) + (p[q][3].z + p[q][3].w)));
            const float r = __builtin_amdgcn_rsqf(sm * (1.0f / 1024.0f) + EPS);
            f32x4* xr = (f32x4*)(a.out + (size_t)m * DM) + lane;
#pragma unroll
            for (int j = 0; j < 4; ++j) { f32x4 v;
                v.x = __uint_as_float(hv[q][j].x << 16); v.y = __uint_as_float(hv[q][j].x & 0xffff0000u); v.z = __uint_as_float(hv[q][j].y << 16); v.w = __uint_as_float(hv[q][j].y & 0xffff0000u);
                xr[64 * j] = v * r * gv[j]; } }
    }
}

__device__ __forceinline__ int crow(int i, int h) { return (i & 3) + 8 * (i >> 2) + 4 * h; }
__device__ __forceinline__ bf16x8 pack8(const f32x16& s, int o) {
    u32x4 w; w.x = cvtpk(s[o + 0], s[o + 1]); w.y = cvtpk(s[o + 2], s[o + 3]); w.z = cvtpk(s[o + 4], s[o + 5]); w.w = cvtpk(s[o + 6], s[o + 7]);
    return __builtin_bit_cast(bf16x8, w);
}
__device__ __forceinline__ f32x16 zero16() { f32x16 z;
#pragma unroll
    for (int i = 0; i < 16; ++i) z[i] = 0.f;
    return z; }
typedef short v4i16_t __attribute__((ext_vector_type(4)));
__device__ __forceinline__ s16x4 vtr(LAS unsigned char* p) { return __builtin_bit_cast(s16x4, __builtin_amdgcn_ds_read_tr16_b64_v4i16((LAS v4i16_t*)p)); }
__device__ __forceinline__ void store_ot(bf16* dst, const f32x16& o0, const f32x16& o1, float rs, int h) {
#pragma unroll
    for (int g = 0; g < 4; ++g) {
        u32x2 w0; w0.x = cvtpk(o0[4 * g] * rs, o0[4 * g + 1] * rs); w0.y = cvtpk(o0[4 * g + 2] * rs, o0[4 * g + 3] * rs);
        u32x2 w1; w1.x = cvtpk(o1[4 * g] * rs, o1[4 * g + 1] * rs); w1.y = cvtpk(o1[4 * g + 2] * rs, o1[4 * g + 3] * rs);
        *(u32x2*)(dst + 8 * g + 4 * h) = w0; *(u32x2*)(dst + 32 + 8 * g + 4 * h) = w1;
    }
}
__device__ __forceinline__ void pack_ot(u32x4 (&pk)[4], const f32x16& o0, const f32x16& o1) {
#pragma unroll
    for (int g2 = 0; g2 < 2; ++g2) {
        pk[g2].x = cvtpk(o0[8 * g2], o0[8 * g2 + 1]); pk[g2].y = cvtpk(o0[8 * g2 + 2], o0[8 * g2 + 3]); pk[g2].z = cvtpk(o0[8 * g2 + 4], o0[8 * g2 + 5]); pk[g2].w = cvtpk(o0[8 * g2 + 6], o0[8 * g2 + 7]);
        pk[2 + g2].x = cvtpk(o1[8 * g2], o1[8 * g2 + 1]); pk[2 + g2].y = cvtpk(o1[8 * g2 + 2], o1[8 * g2 + 3]); pk[2 + g2].z = cvtpk(o1[8 * g2 + 4], o1[8 * g2 + 5]); pk[2 + g2].w = cvtpk(o1[8 * g2 + 6], o1[8 * g2 + 7]); }
}
__device__ __forceinline__ void store_pk(bf16* dst, const u32x4 (&pk)[4], float rs, int h) {
#pragma unroll
    for (int i = 0; i < 4; ++i) { float f[8]; unpack8(pk[i], f); const int dt = i >> 1, g0 = 2 * (i & 1);
        u32x2 w0; w0.x = cvtpk(f[0] * rs, f[1] * rs); w0.y = cvtpk(f[2] * rs, f[3] * rs);
        u32x2 w1; w1.x = cvtpk(f[4] * rs, f[5] * rs); w1.y = cvtpk(f[6] * rs, f[7] * rs);
        *(u32x2*)(dst + 32 * dt + 8 * g0 + 4 * h) = w0; *(u32x2*)(dst + 32 * dt + 8 * (g0 + 1) + 4 * h) = w1; }
}
__device__ __forceinline__ void store_pk_lds(LAS unsigned char* wbuf, bf16* gbase, const u32x4 (&pk)[4], float rs, int r, int h, int lane) {
#pragma unroll
    for (int i = 0; i < 4; ++i) { float f[8]; unpack8(pk[i], f); const int c0 = 4 * (i >> 1) + 2 * (i & 1);
        u32x2 w0; w0.x = cvtpk(f[0] * rs, f[1] * rs); w0.y = cvtpk(f[2] * rs, f[3] * rs);
        u32x2 w1; w1.x = cvtpk(f[4] * rs, f[5] * rs); w1.y = cvtpk(f[6] * rs, f[7] * rs);
        *(LAS u32x2*)(wbuf + r * 128 + ((c0 ^ (r & 7)) << 4) + 8 * h) = w0; *(LAS u32x2*)(wbuf + r * 128 + (((c0 + 1) ^ (r & 7)) << 4) + 8 * h) = w1; }
#pragma unroll
    for (int k = 0; k < 4; ++k) { const int row = (lane >> 3) + 8 * k, pc = lane & 7, lc = pc ^ (row & 7);
        const u32x4 v = *(const LAS u32x4*)(wbuf + row * 128 + pc * 16);
        *(u32x4*)(gbase + (size_t)row * DM + 8 * lc) = v; }
}
__device__ __forceinline__ float sumsq16(const f32x16& o) { float s = 0.f;
#pragma unroll
    for (int i = 0; i < 16; ++i) s += o[i] * o[i];
    return s; }

__device__ __forceinline__ void mixer_phase(LAS unsigned char* lds, const bf16* __restrict__ P, const bf16* __restrict__ MK, const bf16* __restrict__ VT, const float* __restrict__ convw,
                                            const float* __restrict__ sinks, bf16* __restrict__ mixed, int layer, int G, int bid, const int tid_arg, const int var) {
    const int tid_in = tid_arg;
    LAS float* ssqS = (LAS float*)(lds + 98304);
    LAS float* ssqM = (LAS float*)(lds + 98304 + 2048);
    LAS float* rsT = (LAS float*)(lds + 98304 + 3072);
    for (int u = bid; u < 512; u += G) {
        int tid = tid_in; asm volatile("" : "+v"(tid));
        const int lane = tid & 63, w = __builtin_amdgcn_readfirstlane(tid >> 6), r = lane & 31, h = lane >> 5;
        const int b = u >> 6, q0 = (u & 63) * 64; const size_t tok0 = (size_t)b * SEQ + q0;
        if (!(var & 8)) {
#pragma unroll
            for (int ps = 0; ps < 12; ++ps) {
                const int blk = ps * 8 + w, isV = blk >= 48 ? 1 : 0, kb = blk - 48 * isV, kvh = kb >= 24 ? 1 : 0, key = 8 * (kb - 24 * kvh) + (lane >> 3), s16 = lane & 7;
                const int c8 = isV ? ((((s16 >> 2) ^ ((key >> 1) & 1)) << 2) | (s16 & 3)) : (s16 ^ ((key >> 1) & 7));
                int pos = q0 - 128 + key; pos = pos < 0 ? 0 : pos;
                const bf16* src = P + ((size_t)b * SEQ + pos) * DIN + 1280 + isV * 128 + kvh * 64 + c8 * 8;
                __builtin_amdgcn_global_load_lds((const unsigned*)src, (LAS unsigned*)(lds + blk * 1024), 16, 0, 0);
            }
        }
        if (!(var & 1)) {
            const int c8 = tid & 31, tg = tid >> 5, c0 = c8 * 8, t0 = 4 * tg;
            float w0[8], w1[8], w2[8];
            { const f32x4 a0 = *(const f32x4*)(convw + c0), a1 = *(const f32x4*)(convw + c0 + 4), b0 = *(const f32x4*)(convw + 256 + c0), b1 = *(const f32x4*)(convw + 256 + c0 + 4),
                          d0 = *(const f32x4*)(convw + 512 + c0), d1 = *(const f32x4*)(convw + 512 + c0 + 4);
#pragma unroll
              for (int j = 0; j < 4; ++j) { w0[j] = a0[j]; w0[4 + j] = a1[j]; w1[j] = b0[j]; w1[4 + j] = b1[j]; w2[j] = d0[j]; w2[4 + j] = d1[j]; } }
            const bool halo = (q0 + t0 - 2 >= 0); const size_t th = halo ? (tok0 + t0 - 2) : tok0;
            u32x4 rh[2][2], rt[4][3];
#pragma unroll
            for (int i = 0; i < 2; ++i) { const bf16* pp = P + (th + i) * DIN + c0; rh[i][0] = *(const u32x4*)(pp + 256); rh[i][1] = *(const u32x4*)(pp + 512); }
#pragma unroll
            for (int i = 0; i < 4; ++i) { const bf16* pp = P + (tok0 + t0 + i) * DIN + c0; rt[i][0] = *(const u32x4*)(pp); rt[i][1] = *(const u32x4*)(pp + 256); rt[i][2] = *(const u32x4*)(pp + 512); }
            float vm2[8], vm1[8];
            { float cg_[8], uu[8]; const float hz = halo ? 1.0f : 0.0f;
              unpack8(rh[0][0], cg_); unpack8(rh[0][1], uu);
#pragma unroll
              for (int j = 0; j < 8; ++j) vm2[j] = cg_[j] * uu[j] * hz;
              unpack8(rh[1][0], cg_); unpack8(rh[1][1], uu);
#pragma unroll
              for (int j = 0; j < 8; ++j) vm1[j] = cg_[j] * uu[j] * hz; }
#pragma unroll
            for (int i = 0; i < 4; ++i) {
                float bg[8], cg_[8], uu[8], y[8];
                unpack8(rt[i][0], bg); unpack8(rt[i][1], cg_); unpack8(rt[i][2], uu);
                float sq = 0.f;
#pragma unroll
                for (int j = 0; j < 8; ++j) { const float v = cg_[j] * uu[j]; y[j] = bg[j] * (w0[j] * vm2[j] + w1[j] * vm1[j] + w2[j] * v); vm2[j] = vm1[j]; vm1[j] = v; sq += y[j] * y[j]; }
#pragma unroll
                for (int o = 1; o < 32; o <<= 1) sq += __shfl_xor(sq, o);
                const float rs = __builtin_amdgcn_rsqf(sq * (1.0f / 256.0f) + EPS);
                u32x4 wv; wv.x = cvtpk(y[0] * rs, y[1] * rs); wv.y = cvtpk(y[2] * rs, y[3] * rs); wv.z = cvtpk(y[4] * rs, y[5] * rs); wv.w = cvtpk(y[6] * rs, y[7] * rs);
                *(u32x4*)(mixed + (tok0 + t0 + i) * DM + c0) = wv;
            }
        }
        asm volatile("s_waitcnt vmcnt(0)" ::: "memory");
        __syncthreads();
        u32x4 HM[4] = {};
        u32x4 HS[2][4] = {};
#pragma unroll 1
        for (int step = 0; step < 2; ++step) {
        if ((step == 0) == (w < 4)) {
        if (!(var & 2)) {
            const int hm = w >> 1, qt = w & 1;
            const bf16* qp = P + (tok0 + 32 * qt + r) * DIN + 1536 + hm * 64 + 8 * h;
            bf16x8 qf[4];
#pragma unroll
            for (int ks = 0; ks < 4; ++ks) qf[ks] = *(const bf16x8*)(qp + 16 * ks);
            const bf16* kp = MK + (size_t)(b * MEML + r) * 512 + layer * 256 + hm * 64 + 8 * h;
            const bf16* vp = VT + (size_t)(layer * 256 + hm * 64 + r) * NMEM + b * MEML + 8 * h;
            const float c = 0.125f * LOG2E;
            f32x16 o0 = zero16(), o1 = zero16(); float mrun = -INFINITY, lrun = 0.f;
#pragma unroll 1
            for (int hf = 0; hf < 2; ++hf) {
                f32x16 S[4];
#pragma unroll
                for (int jp = 0; jp < 2; ++jp) {
                    bf16x8 kf[2][4];
#pragma unroll
                    for (int j2 = 0; j2 < 2; ++j2)
#pragma unroll
                        for (int ks = 0; ks < 4; ++ks) kf[j2][ks] = *(const bf16x8*)(kp + (size_t)(4 * hf + 2 * jp + j2) * 32 * 512 + 16 * ks);
                    __builtin_amdgcn_sched_barrier(0);
#pragma unroll
                    for (int j2 = 0; j2 < 2; ++j2) { S[2 * jp + j2] = zero16();
#pragma unroll
                        for (int ks = 0; ks < 4; ++ks) S[2 * jp + j2] = __builtin_amdgcn_mfma_f32_32x32x16_bf16(kf[j2][ks], qf[ks], S[2 * jp + j2], 0, 0, 0); }
                    __builtin_amdgcn_sched_barrier(0);
                }
                float mx = mrun;
#pragma unroll
                for (int jt = 0; jt < 4; ++jt)
#pragma unroll
                    for (int i = 0; i < 16; ++i) mx = fmaxf(mx, S[jt][i] * c);
                mx = xmax32(mx);
                const float alpha = __builtin_amdgcn_exp2f(mrun - mx);
                float sum = 0.f;
#pragma unroll
                for (int jt = 0; jt < 4; ++jt)
#pragma unroll
                    for (int i = 0; i < 16; ++i) { const float p = __builtin_amdgcn_exp2f(S[jt][i] * c - mx); S[jt][i] = p; sum += p; }
                sum = xsum32(sum);
                lrun = lrun * alpha + sum; mrun = mx;
                o0 = o0 * alpha; o1 = o1 * alpha;
#pragma unroll
                for (int jp = 0; jp < 2; ++jp) {
                    bf16x8 vf[2][2][2];
#pragma unroll
                    for (int j2 = 0; j2 < 2; ++j2)
#pragma unroll
                        for (int s = 0; s < 2; ++s) { const int ko = 32 * (4 * hf + 2 * jp + j2) + 16 * s; vf[j2][s][0] = *(const bf16x8*)(vp + ko); vf[j2][s][1] = *(const bf16x8*)(vp + (size_t)32 * NMEM + ko); }
                    __builtin_amdgcn_sched_barrier(0);
#pragma unroll
                    for (int j2 = 0; j2 < 2; ++j2)
#pragma unroll
                        for (int s = 0; s < 2; ++s) { const bf16x8 pb = pack8(S[2 * jp + j2], 8 * s);
                            o0 = __builtin_amdgcn_mfma_f32_32x32x16_bf16(vf[j2][s][0], pb, o0, 0, 0, 0); o1 = __builtin_amdgcn_mfma_f32_32x32x16_bf16(vf[j2][s][1], pb, o1, 0, 0, 0); }
                    __builtin_amdgcn_sched_barrier(0);
                }
            }
            const float inv = __builtin_amdgcn_rcpf(lrun);
            o0 = o0 * inv; o1 = o1 * inv;
            float sq = sumsq16(o0) + sumsq16(o1); sq = xsum32(sq);
            if (h == 0) ssqM[hm * 64 + 32 * qt + r] = sq;
            pack_ot(HM, o0, o1);
            __builtin_amdgcn_sched_barrier(0);
        }
        } else {
        if (!(var & 4)) {
            const int kvh = w >> 2;
            const float slope2 = __builtin_amdgcn_exp2f(-(float)(w + 1)) * LOG2E, sink2 = sinks[w] * LOG2E, c = 0.125f * LOG2E;
            const int sjmin = 128 - q0;
            LAS unsigned char* Kb = lds + kvh * 24576;
            const int qq = (lane & 15) >> 2, xh = (qq >> 1) & 1;
            LAS unsigned char* Vb = lds + 49152 + kvh * 24576 + (4 * h + qq) * 128 + ((2 * ((lane >> 4) & 1) + ((lane & 3) >> 1)) << 4) + 8 * (lane & 1);
            LAS unsigned char* Vb0 = Vb + (xh << 6); LAS unsigned char* Vb1 = Vb + ((xh ^ 1) << 6);
#pragma unroll
            for (int qt = 0; qt < 2; ++qt) {
                const bf16* qp = P + (tok0 + 32 * qt + r) * DIN + 768 + w * 64 + 8 * h;
                bf16x8 qf[4];
#pragma unroll
                for (int ks = 0; ks < 4; ++ks) qf[ks] = *(const bf16x8*)(qp + 16 * ks);
                f32x16 S[5];
#pragma unroll
                for (int tp = 0; tp < 3; ++tp) {
                    bf16x8 kf[2][4];
#pragma unroll
                    for (int j2 = 0; j2 < 2; ++j2) { const int t5 = 2 * tp + j2; if (t5 < 5) { const int key = 32 * (qt + t5) + r;
#pragma unroll
                        for (int ks = 0; ks < 4; ++ks) kf[j2][ks] = *(const LAS bf16x8*)(Kb + key * 128 + (((2 * ks + h) ^ ((key >> 1) & 7)) << 4)); } }
                    __builtin_amdgcn_sched_barrier(0);
#pragma unroll
                    for (int j2 = 0; j2 < 2; ++j2) { const int t5 = 2 * tp + j2; if (t5 < 5) { S[t5] = zero16();
#pragma unroll
                        for (int ks = 0; ks < 4; ++ks) S[t5] = __builtin_amdgcn_mfma_f32_32x32x16_bf16(kf[j2][ks], qf[ks], S[t5], 0, 0, 0); } }
                    __builtin_amdgcn_sched_barrier(0);
                }
                const int qi = 32 * qt + r; float mx = sink2;
                int hq = h; asm volatile("" : "+v"(hq));
#pragma unroll
                for (int t5 = 0; t5 < 5; ++t5)
#pragma unroll
                    for (int i = 0; i < 16; ++i) { const int sj = 32 * (qt + t5) + crow(i, hq), dist = qi + 128 - sj; const bool ok = (dist >= 0) && (dist < 128) && (sj >= sjmin);
                        const float v = ok ? S[t5][i] * c - slope2 * (float)dist : -INFINITY; S[t5][i] = v; mx = fmaxf(mx, v); }
                mx = xmax32(mx);
                float sum = 0.f;
#pragma unroll
                for (int t5 = 0; t5 < 5; ++t5)
#pragma unroll
                    for (int i = 0; i < 16; ++i) { const float p = __builtin_amdgcn_exp2f(S[t5][i] - mx); S[t5][i] = p; sum += p; }
                sum = xsum32(sum); sum += __builtin_amdgcn_exp2f(sink2 - mx);
                f32x16 o0 = zero16(), o1 = zero16();
#pragma unroll
                for (int t5 = 0; t5 < 5; ++t5) {
                    s16x4 tv[2][4];
#pragma unroll
                    for (int s = 0; s < 2; ++s) { const int ko = (32 * (qt + t5) + 16 * s) * 128; tv[s][0] = vtr(Vb0 + ko); tv[s][1] = vtr(Vb0 + ko + 8 * 128); tv[s][2] = vtr(Vb1 + ko); tv[s][3] = vtr(Vb1 + ko + 8 * 128); }
                    __builtin_amdgcn_sched_barrier(0);
#pragma unroll
                    for (int s = 0; s < 2; ++s) { const bf16x8 pb = pack8(S[t5], 8 * s);
                        const bf16x8 v0 = {tv[s][0][0], tv[s][0][1], tv[s][0][2], tv[s][0][3], tv[s][1][0], tv[s][1][1], tv[s][1][2], tv[s][1][3]}, v1 = {tv[s][2][0], tv[s][2][1], tv[s][2][2], tv[s][2][3], tv[s][3][0], tv[s][3][1], tv[s][3][2], tv[s][3][3]};
                        o0 = __builtin_amdgcn_mfma_f32_32x32x16_bf16(v0, pb, o0, 0, 0, 0); o1 = __builtin_amdgcn_mfma_f32_32x32x16_bf16(v1, pb, o1, 0, 0, 0); }
                    __builtin_amdgcn_sched_barrier(0);
                }
                const float inv = __builtin_amdgcn_rcpf(sum);
                o0 = o0 * inv; o1 = o1 * inv;
                float sq = sumsq16(o0) + sumsq16(o1); sq = xsum32(sq);
                if (h == 0) ssqS[w * 64 + qi] = sq;
                pack_ot(HS[qt], o0, o1);
                __builtin_amdgcn_sched_barrier(0);
            }
        }
        }
        }
        __syncthreads();
        if (!(var & 16)) {
            const int hm = w >> 1, qm = 32 * (w & 1) + r;
            const float totm = (ssqM[qm] + ssqM[64 + qm]) + (ssqM[128 + qm] + ssqM[192 + qm]);
            LAS unsigned char* wb = lds + w * 12288;
            store_pk_lds(wb, mixed + (tok0 + 32 * (w & 1)) * DM + 768 + hm * 64, HM, __builtin_amdgcn_rsqf(totm * (1.0f / 256.0f) + EPS), r, h, lane);
#pragma unroll
            for (int qt = 0; qt < 2; ++qt) { const int q = 32 * qt + r; float tot = 0.f;
#pragma unroll
                for (int hh = 0; hh < 8; ++hh) tot += ssqS[hh * 64 + q];
                store_pk_lds(wb + 4096 * (qt + 1), mixed + (tok0 + 32 * qt) * DM + 256 + w * 64, HS[qt], __builtin_amdgcn_rsqf(tot * (1.0f / 512.0f) + EPS), r, h, lane); }
        }
        __syncthreads();
    }
}


#define XB_TMO      128
#define XB_XCNT(j)  (256  + 64 * (j))
#define XB_XSUB(j)  (1280 + 64 * (j))
#define XB_XGEN(j)  (2304 + 64 * (j))
#define XB_TOP      3328
#define XB_TOPGEN   3392
#define XCD_BAR_WORDS 3456
#define XB_SPIN_CAP (1u << 18)

__device__ __forceinline__ unsigned xb_ld(unsigned* p)              { return __hip_atomic_load(p, __ATOMIC_RELAXED, __HIP_MEMORY_SCOPE_AGENT); }
__device__ __forceinline__ unsigned xb_add(unsigned* p, unsigned v) { return __hip_atomic_fetch_add(p, v, __ATOMIC_RELAXED, __HIP_MEMORY_SCOPE_AGENT); }
__device__ __forceinline__ unsigned xb_xcc_id() { return (unsigned)__builtin_amdgcn_s_getreg((3 << 11) | 20) & 0xFu; }
#define XB_SPIN(cond, bar) do { unsigned _sp = 0; while (cond) { __builtin_amdgcn_s_sleep(1); \
    if ((++_sp & 255u) == 0u) { if (xb_ld(&(bar)[XB_TMO])) break; if (_sp > XB_SPIN_CAP) { atomicAdd(&(bar)[XB_TMO], 1u); break; } } } } while (0)

struct XcdBarrier {
    unsigned* bar; unsigned x;
    volatile LAS unsigned* st;
};

__device__ __forceinline__ XcdBarrier xcd_barrier_post(unsigned* bar, volatile LAS unsigned* st) {
    XcdBarrier b; b.bar = bar; b.x = xb_xcc_id(); b.st = st;
    if (threadIdx.x == 0) (void)xb_add(&bar[XB_XCNT(b.x)], 1u);
    return b;
}
__device__ __forceinline__ void xcd_barrier_complete(unsigned* bar, unsigned x, unsigned& nloc, unsigned& nx) {
    const unsigned G = gridDim.x * gridDim.y * gridDim.z;
    unsigned sum, cnt, mine, sp = 0u;
    for (;;) {
        sum = 0u; cnt = 0u; mine = 0u;
#pragma unroll
        for (unsigned j = 0; j < 16; ++j) { const unsigned c = xb_ld(&bar[XB_XCNT(j)]); sum += c; cnt += (c > 0u) ? 1u : 0u; mine = (j == x) ? c : mine; }
        if (sum == G) break;
        __builtin_amdgcn_s_sleep(1);
        if ((++sp & 255u) == 0u) { if (xb_ld(&bar[XB_TMO])) break; if (sp > XB_SPIN_CAP) { atomicAdd(&bar[XB_TMO], 1u); break; } }
    }
    nloc = mine > 0u ? mine : 1u; nx = cnt > 0u ? cnt : 1u;
}

__device__ __forceinline__ void xcd_barrier(const XcdBarrier& b) {
    asm volatile("s_waitcnt vmcnt(0)" ::: "memory");
    __syncthreads();
    if (threadIdx.x == 0) {
        unsigned* bar = b.bar;
        __builtin_amdgcn_s_waitcnt(0);
        unsigned nloc = b.st[0], nx = b.st[1];
        if (nloc == 0u) { xcd_barrier_complete(bar, b.x, nloc, nx); b.st[0] = nloc; b.st[1] = nx; }
        const unsigned old = xb_add(&bar[XB_XSUB(b.x)], 1u);
        const unsigned gen = old / nloc;
        if (old + 1u == (gen + 1u) * nloc) {
            __builtin_amdgcn_fence(__ATOMIC_RELEASE, "agent");
            asm volatile("s_waitcnt vmcnt(0)" ::: "memory");
            const unsigned og = xb_add(&bar[XB_TOP], 1u);
            const unsigned tg = og / nx;
            if (og + 1u == (tg + 1u) * nx) xb_add(&bar[XB_TOPGEN], 1u);
            else XB_SPIN(xb_ld(&bar[XB_TOPGEN]) == tg, bar);
            __builtin_amdgcn_fence(__ATOMIC_ACQUIRE, "agent");
            xb_add(&bar[XB_XGEN(b.x)], 1u);
            asm volatile("s_waitcnt vmcnt(0)" ::: "memory");
        } else {
            XB_SPIN(xb_ld(&bar[XB_XGEN(b.x)]) == gen, bar);
            __builtin_amdgcn_fence(__ATOMIC_ACQUIRE, "agent");
            asm volatile("s_waitcnt vmcnt(0)" ::: "memory");
        }
    }
    __syncthreads();
}


__global__ void __launch_bounds__(512) fwd_kernel(Args a) {
    extern __shared__ __attribute__((aligned(16))) unsigned char lds_raw[];
    LAS unsigned char* lds = (LAS unsigned char*)lds_raw;
    if (threadIdx.x < 16) ((LAS unsigned*)(lds + LDS_BARW))[threadIdx.x] = 0u;
    __syncthreads();
    XcdBarrier bar; bar.bar = (unsigned*)(a.ws + WS_CTL); bar.x = 0; bar.st = nullptr;
    if (a.coop) bar = xcd_barrier_post((unsigned*)(a.ws + WS_CTL), (volatile LAS unsigned*)(lds + LDS_BARW));
    int ph0 = a.ph_lo;
    if (ph0 == 0) {
        int tid = threadIdx.x; asm volatile("" : "+v"(tid));
        const int lane = tid & 63, wave = __builtin_amdgcn_readfirstlane(tid >> 6), gw = (int)blockIdx.x * 8 + wave, NGW = (int)gridDim.x * 8;
        prologue(a, lds, gw, NGW, wave, lane);
        ph0 = 1;
        if (ph0 < a.ph_hi) { if (a.coop == 2) cg::this_grid().sync(); else if (a.coop) xcd_barrier(bar); else __syncthreads(); }
    }
    for (int ph = ph0; ph < a.ph_hi; ++ph) {
      const int reps = 1 + MK_DUPN * ((a.dup >> ph) & 1);
      for (int rep = 0; rep < reps; ++rep) {
        if (MK_STAG > 0 && (ph == 1 || ph == 6 || ph == 8 || ph == 13) && (blockIdx.x & 1)) {
#pragma unroll 1
            for (int i = 0; i < MK_STAG; ++i) __builtin_amdgcn_s_sleep(127); }
        int tid = threadIdx.x; asm volatile("" : "+v"(tid));
        int G = gridDim.x, bid = blockIdx.x; asm volatile("" : "+s"(G), "+s"(bid));
        size_t wz = 0; asm volatile("" : "+s"(wz));
        unsigned char* ws = a.ws + wz;
        const int lane = tid & 63, wave = __builtin_amdgcn_readfirstlane(tid >> 6), gw = bid * 8 + wave, NGW = G * 8;
        float* ss = (float*)(ws + WS_SS); bf16* hb = (bf16*)(ws + WS_HB); bf16* act = (bf16*)(ws + WS_ACT); bf16* Pb = (bf16*)(ws + WS_P); bf16* mixed = (bf16*)(ws + WS_MIXED);
        if (ph == NPHASE - 1) final_norm(a, gw, NGW, lane);
        else {
            const int l = (ph - 1) / 7, s = (ph - 1) % 7;
            unsigned char* wl = ws + WS_W0 + (size_t)l * WS_WL;
            if (s == 0 || s == 5) {
                pg8::Gemm g{hb, (const bf16*)(wl + (s == 0 ? OFF_WUP1 : OFF_WUP2)), NTOK, 2 * DFF, DM}; pg8::StaticOrder S; S.init(NTOK, 2 * DFF, G, bid);
                EpiSwiglu E{act, ss, (rep + 1 < reps) ? MK_SKIPEPI : 0};
                pg8::gemm_phase<EpiSwiglu, pg8::StaticOrder, true, true>(lds, g, S, E, tid);
            } else if (s == 1 || s == 4 || s == 6) {
                const bool isout = (s == 4);
                pg8::Gemm g{isout ? mixed : act, (const bf16*)(wl + (s == 1 ? OFF_WDN1 : (s == 4 ? OFF_WOUT : OFF_WDN2))), NTOK, DM, isout ? DM : DFF}; pg8::StaticOrder S; S.init(NTOK, DM, G, bid); S.rev = MK_REV;
                EpiResid E{hb, ss, isout ? 1.0f : 0.5f};
                pg8::gemm_phase<EpiResid, pg8::StaticOrder, true, true>(lds, g, S, E, tid);
            } else if (s == 2) {
                const int ng = (l == 0) ? 3 : 1;
                if (MK_WSTAG > 0 && G == 256 && bid >= (l == 0 ? 160 : 128)) {
#pragma unroll 1
                    for (int i = 0; i < MK_WSTAG; ++i) __builtin_amdgcn_s_sleep(127); }
                for (int gi = 0; gi < ng; ++gi) {
                    pg8::Gemm g; pg8::StaticOrder S; EpiScaleBf16 E;
                    if (gi == 0) { g = pg8::Gemm{hb, (const bf16*)(wl + OFF_WIN), NTOK, DIN, DM}; S.init(NTOK, DIN, G, bid); E = EpiScaleBf16{Pb, DIN, ss}; }
                    else if (gi == 1) { g = pg8::Gemm{(const bf16*)(ws + WS_MEMN), (const bf16*)(ws + WS_WMK), NMEM, 512, DM}; S.init(NMEM, 512, G, (bid + 128) % G); E = EpiScaleBf16{(bf16*)(ws + WS_MK), 512, nullptr}; }
                    else { g = pg8::Gemm{(const bf16*)(ws + WS_WMV), (const bf16*)(ws + WS_MEMNP), 512, NMEM, DM}; S.init(512, NMEM, G, (bid + 112) % G); E = EpiScaleBf16{(bf16*)(ws + WS_VT), NMEM, nullptr}; }
                    pg8::gemm_phase<EpiScaleBf16, pg8::StaticOrder, false, true>(lds, g, S, E, tid);
                }
            } else {
                mixer_phase(lds, Pb, (const bf16*)(ws + WS_MK), (const bf16*)(ws + WS_VT), a.conv_w + l * 768, a.sinks + l * 8, mixed, l, G, bid, tid, (rep + 1 < reps) ? MK_MIXVAR : 0);
            }
        }
        if (ph + 1 < a.ph_hi || rep + 1 < reps) { if (a.coop == 2) cg::this_grid().sync();
          else if (a.coop) xcd_barrier(bar); else __syncthreads(); }
      }
    }
}

extern "C" void kernel_launch(void* const* d_in, const int* in_sizes, int n_in, void* d_out, int out_size, void* d_ws, size_t ws_size, hipStream_t stream) {
    static int grid = 0;
    if (grid == 0) {
        if (n_in != 17 || in_sizes[0] != NTOK * DM || out_size != NTOK * DM || ws_size < WS_TOTAL) { fprintf(stderr, "kernel_launch: unexpected shapes / workspace (n_in %d, ws %zu)\n", n_in, ws_size); grid = -1; return; }
        int dev = 0, cus = 0, per_cu = 0;
        hipGetDevice(&dev); hipDeviceGetAttribute(&cus, hipDeviceAttributeMultiprocessorCount, dev);
        if (hipFuncSetAttribute((const void*)fwd_kernel, hipFuncAttributeMaxDynamicSharedMemorySize, LDS_BYTES) != hipSuccess) { fprintf(stderr, "kernel_launch: hipFuncSetAttribute failed\n"); grid = -1; return; }
        if (hipOccupancyMaxActiveBlocksPerMultiprocessor(&per_cu, (const void*)fwd_kernel, 512, LDS_BYTES) != hipSuccess || per_cu < 1) { fprintf(stderr, "kernel_launch: occupancy query says %d\n", per_cu); per_cu = 1; }
        (void)hipGetLastError();
        grid = cus * 1;
        if (grid <= 0) grid = 256;
    }
    if (grid < 0) return;
    if (hipMemsetAsync((char*)d_ws + WS_CTL, 0, CTL_BYTES, stream) != hipSuccess) { fprintf(stderr, "kernel_launch: memset of the barrier words failed\n"); return; }
    Args a{};
    const float** ap = (const float**)&a;
    for (int i = 0; i < 17; ++i) ap[i] = (const float*)d_in[i];
    a.out = (float*)d_out; a.ws = (unsigned char*)d_ws;
#if MK_ONE_LAUNCH
    a.ph_lo = 0; a.ph_hi = NPHASE; a.coop = 1; a.dup = MK_DUP;
    void* args[] = {&a};
    hipError_t e = hipLaunchCooperativeKernel((const void*)fwd_kernel, dim3(grid), dim3(512), args, LDS_BYTES, stream);
    if (e != hipSuccess) fprintf(stderr, "cooperative launch failed: %s (grid %d)\n", hipGetErrorString(e), grid);
#else
    for (int ph = 0; ph < NPHASE; ++ph) {
        a.ph_lo = ph; a.ph_hi = ph + 1; a.coop = 0;
        hipLaunchKernelGGL(fwd_kernel, dim3(grid), dim3(512), LDS_BYTES, stream, a);
    }
#endif
}
```
